# Optimizing an MI355X kernel written in HIP

```python
import jax, jax.numpy as jnp
from jax import lax
import numpy as np

D_MODEL = 1024
BATCH = 2
SEQ = 16384
DEPTH = 1
DEC_BATCH = 16
DEC_SEQ = 64
PAST_LEN = 4096

CHUNK = 64
MIX_WIDTH = D_MODEL
CONV_CH = MIX_WIDTH // 2
POOL_CH = MIX_WIDTH - CONV_CH
CONV_WIDTH = 31
CONV_HIST = CONV_WIDTH - 1
POOL_WINDOWS = (2, 4, 8, 16)
N_POOL_GROUPS = len(POOL_WINDOWS)
POOL_GROUP = POOL_CH // N_POOL_GROUPS
POOL_HIST = max(POOL_WINDOWS) - 1
IN_COLS = 2 * CONV_CH + POOL_CH
D_FF = ((8 * D_MODEL // 3 + 127) // 128) * 128
N_MOD = 9
ALPHA = (2.0 * DEPTH) ** 0.25
BETA = (8.0 * DEPTH) ** -0.25
LN_EPS = 1e-5

kernel_name = 'hybrid_conv_pool_streaming_encoder_step'


def _layernorm(x, g, b):
    xf = x.astype(jnp.float32)
    mu = jnp.mean(xf, axis=-1, keepdims=True)
    var = jnp.mean(jnp.square(xf - mu), axis=-1, keepdims=True)
    return ((xf - mu) * lax.rsqrt(var + LN_EPS)).astype(x.dtype) * g + b


def _swiglu(u, w_in, w_down):
    g, v = jnp.split(u @ w_in, 2, axis=-1)
    return (jax.nn.silu(g) * v) @ w_down


def _token_mixer(u, conv_hist, pool_hist, pos, w_in, b_in, conv_w, conv_b, cln_g, cln_b,
                 pool_w, pool_b, pool_scale, w_out, b_out):
    B, T, _ = u.shape
    z = u @ w_in + b_in
    za = z[..., :CONV_CH]
    zb = z[..., CONV_CH:2 * CONV_CH]
    zp = z[..., 2 * CONV_CH:]
    glu = za * jax.nn.sigmoid(zb)
    cin = jnp.concatenate([conv_hist.astype(glu.dtype), glu], axis=1)
    conv = lax.conv_general_dilated(cin, conv_w[:, None, :].astype(cin.dtype), window_strides=(1,),
                                    padding='VALID', dimension_numbers=('NWC', 'WIO', 'NWC'),
                                    feature_group_count=CONV_CH) + conv_b
    a = jax.nn.silu(_layernorm(conv, cln_g, cln_b))
    pin = jnp.concatenate([pool_hist.astype(zp.dtype), zp], axis=1)
    cs = jnp.pad(jnp.cumsum(pin.astype(jnp.float32), axis=1), ((0, 0), (1, 0), (0, 0)))
    end = cs[:, POOL_HIST + 1:]
    zp_f = zp.astype(jnp.float32)
    groups = []
    for g, w in enumerate(POOL_WINDOWS):
        sl = slice(g * POOL_GROUP, (g + 1) * POOL_GROUP)
        wsum = end[..., sl] - cs[:, POOL_HIST + 1 - w:POOL_HIST + 1 - w + T, sl]
        cnt = jnp.minimum(pos + 1, w).astype(jnp.float32)[None, :, None]
        groups.append(wsum / cnt - zp_f[..., sl])
    pooled = jnp.stack(groups, axis=2).astype(u.dtype)
    pm = jnp.einsum('btgc,gcd->btgd', pooled, pool_w) + pool_b
    pm = pm.reshape(B, T, POOL_CH) * pool_scale
    y = jnp.concatenate([a, pm], axis=-1) @ w_out + b_out
    return y, cin[:, -CONV_HIST:], pin[:, -POOL_HIST:]


def _trunk(x, c, conv_cache, pool_cache, pos0, ada_w, ada_b, ln_g, ln_b, ffn_w_in, ffn_w_down,
           mix_w_in, mix_b_in, conv_w, conv_b, conv_ln_g, conv_ln_b, pool_w, pool_b, pool_scale,
           mix_w_out, mix_b_out):
    B, T, _ = x.shape
    pos = pos0 + jnp.arange(T)
    new_conv, new_pool = [], []
    for l in range(DEPTH):
        mod = (jax.nn.silu(c) @ ada_w[l] + ada_b[l]).reshape(B, N_MOD, 1, D_MODEL)
        shift = lambda k: mod[:, 3 * k]
        scale = lambda k: mod[:, 3 * k + 1]
        gate = lambda k: mod[:, 3 * k + 2]
        u = x * (1 + scale(0)) + shift(0)
        x = _layernorm(ALPHA * x + 0.5 * gate(0) * _swiglu(u, ffn_w_in[l, 0], ffn_w_down[l, 0]),
                       ln_g[l, 0], ln_b[l, 0])
        u = x * (1 + scale(1)) + shift(1)
        m, hc, hp = _token_mixer(u, conv_cache[l], pool_cache[l], pos, mix_w_in[l], mix_b_in[l],
                                 conv_w[l], conv_b[l], conv_ln_g[l], conv_ln_b[l], pool_w[l],
                                 pool_b[l], pool_scale[l], mix_w_out[l], mix_b_out[l])
        x = _layernorm(ALPHA * x + gate(1) * m, ln_g[l, 1], ln_b[l, 1])
        u = x * (1 + scale(2)) + shift(2)
        x = _layernorm(ALPHA * x + 0.5 * gate(2) * _swiglu(u, ffn_w_in[l, 1], ffn_w_down[l, 1]),
                       ln_g[l, 2], ln_b[l, 2])
        new_conv.append(hc)
        new_pool.append(hp)
    return x, jnp.stack(new_conv, axis=0), jnp.stack(new_pool, axis=0)


def setup_inputs(seed: int = 0) -> dict:
    key = jax.random.key(seed)
    ks = jax.random.split(key, 24)
    f32 = jnp.float32
    def n(k, shape, s):
        return jax.random.normal(k, shape, f32) * s
    return {
        'x_prompt': n(ks[0], (BATCH, SEQ, D_MODEL), 1.0),
        'x_sample': n(ks[1], (DEC_BATCH, DEC_SEQ, D_MODEL), 1.0),
        'cache_conv': n(ks[2], (DEPTH, DEC_BATCH, CONV_HIST, CONV_CH), 0.5),
        'cache_pool': n(ks[3], (DEPTH, DEC_BATCH, POOL_HIST, POOL_CH), 1.0),
        'c_prompt': n(ks[4], (BATCH, D_MODEL), 1.0),
        'c_sample': n(ks[5], (DEC_BATCH, D_MODEL), 1.0),
        'ada_w': n(ks[6], (DEPTH, D_MODEL, N_MOD * D_MODEL), D_MODEL ** -0.5),
        'ada_b': n(ks[7], (DEPTH, N_MOD * D_MODEL), 0.02),
        'ln_g': 1.0 + n(ks[8], (DEPTH, 3, D_MODEL), 0.05),
        'ln_b': n(ks[9], (DEPTH, 3, D_MODEL), 0.02),
        'ffn_w_in': n(ks[10], (DEPTH, 2, D_MODEL, 2 * D_FF), D_MODEL ** -0.5),
        'ffn_w_down': n(ks[11], (DEPTH, 2, D_FF, D_MODEL), BETA * D_FF ** -0.5),
        'mix_w_in': n(ks[12], (DEPTH, D_MODEL, IN_COLS), D_MODEL ** -0.5),
        'mix_b_in': n(ks[13], (DEPTH, IN_COLS), 0.02),
        'conv_w': n(ks[14], (DEPTH, CONV_WIDTH, CONV_CH), CONV_WIDTH ** -0.5),
        'conv_b': n(ks[15], (DEPTH, CONV_CH), 0.02),
        'conv_ln_g': 1.0 + n(ks[16], (DEPTH, CONV_CH), 0.05),
        'conv_ln_b': n(ks[17], (DEPTH, CONV_CH), 0.02),
        'pool_w': n(ks[18], (DEPTH, N_POOL_GROUPS, POOL_GROUP, POOL_GROUP), POOL_GROUP ** -0.5),
        'pool_b': n(ks[19], (DEPTH, N_POOL_GROUPS, POOL_GROUP), 0.02),
        'pool_scale': 1.0 + n(ks[20], (DEPTH, POOL_CH), 0.1),
        'mix_w_out': n(ks[21], (DEPTH, MIX_WIDTH, D_MODEL), BETA * MIX_WIDTH ** -0.5),
        'mix_b_out': n(ks[22], (DEPTH, D_MODEL), 0.02),
    }


def reference(x_prompt, x_sample, cache_conv, cache_pool, c_prompt, c_sample, ada_w, ada_b, ln_g,
              ln_b, ffn_w_in, ffn_w_down, mix_w_in, mix_b_in, conv_w, conv_b, conv_ln_g, conv_ln_b,
              pool_w, pool_b, pool_scale, mix_w_out, mix_b_out):
    zero_conv = jnp.zeros((DEPTH, x_prompt.shape[0], CONV_HIST, CONV_CH), x_prompt.dtype)
    zero_pool = jnp.zeros((DEPTH, x_prompt.shape[0], POOL_HIST, POOL_CH), x_prompt.dtype)
    y_prompt, state_conv_prompt, state_pool_prompt = _trunk(
        x_prompt, c_prompt, zero_conv, zero_pool, 0, ada_w, ada_b, ln_g, ln_b, ffn_w_in, ffn_w_down,
        mix_w_in, mix_b_in, conv_w, conv_b, conv_ln_g, conv_ln_b, pool_w, pool_b, pool_scale,
        mix_w_out, mix_b_out)
    y_sample, state_conv_sample, state_pool_sample = _trunk(
        x_sample, c_sample, cache_conv, cache_pool, PAST_LEN, ada_w, ada_b, ln_g, ln_b, ffn_w_in,
        ffn_w_down, mix_w_in, mix_b_in, conv_w, conv_b, conv_ln_g, conv_ln_b, pool_w, pool_b,
        pool_scale, mix_w_out, mix_b_out)
    return (y_prompt, y_sample, state_conv_prompt, state_pool_prompt, state_conv_sample, state_pool_sample)
```

```cpp
#include <hip/hip_runtime.h>
#include <hip/hip_cooperative_groups.h>
#include <cstdio>
#include <cstdint>
namespace cg = cooperative_groups;

constexpr int D = 1024, DFF = 2816, T_P = 16384, NB_P = 2, T_S = 64, NB_S = 16;
constexpr int M_P = NB_P * T_P, M_S = NB_S * T_S, M = M_P + M_S;
constexpr int NBATCH = NB_P + NB_S, NMOD = 9 * D;
constexpr int CC = 512, PC = 512, INC = 1536, CW = 31, CH = 30, PH = 15, PAST = 4096;
constexpr float LN_EPS = 1e-5f;
constexpr float ALPHA = 1.189207115002721f;
constexpr size_t OUT_Y = 0, OUT_SCP = (size_t)M * D, OUT_SPP = OUT_SCP + (size_t)NB_P * CH * CC, OUT_SCS = OUT_SPP + (size_t)NB_P * PH * PC,
                 OUT_SPS = OUT_SCS + (size_t)NB_S * CH * CC, OUT_END = OUT_SPS + (size_t)NB_S * PH * PC;
constexpr size_t MiB = 1u << 20;
constexpr size_t WS_CTL = 0, WS_MOD = 1 * MiB, WS_BIAS2 = 1 * MiB + 768 * 1024;
constexpr size_t WS_WIN1 = 2 * MiB, WS_WIN2 = 13 * MiB, WS_WDN1 = 24 * MiB, WS_WDN2 = 30 * MiB, WS_WMI = 36 * MiB, WS_WMO = 39 * MiB;
constexpr size_t WS_U = 48 * MiB;
constexpr size_t WS_ACT = 114 * MiB;
constexpr size_t WS_GLU = WS_ACT, WS_ZP = WS_ACT + 66 * MiB;
constexpr size_t WS_END = 296 * MiB;
static_assert((size_t)NBATCH * NMOD * 4 <= 768 * 1024, "mod");
static_assert(WS_U + (size_t)M * D * 2 <= WS_ACT && WS_ACT + (size_t)M * DFF * 2 <= WS_END && WS_ZP + (size_t)M * PC * 4 <= WS_END, "ws map");
static_assert((size_t)M * CC * 4 == 66 * MiB, "glu size");

__device__ __forceinline__ int batch_of_row(int r) { return r < M_P ? (r >> 14) : NB_P + ((r - M_P) >> 6); }

namespace pg8 {
#define PG8_LAS __attribute__((address_space(3)))
typedef unsigned short bf16_t;
typedef short bf16x8 __attribute__((ext_vector_type(8)));
typedef float f32x4 __attribute__((ext_vector_type(4)));
typedef unsigned u32x4 __attribute__((ext_vector_type(4)));
constexpr int BM = 256, BK = 64, HALF = 128, HTB = HALF * BK * 2  , STAGE_BYTES = 8 * HTB, NXCD = 8, WGM = 8;

__host__ __device__ __forceinline__ int lds_byte(int r, int c) { const int st = (r >> 4) * 2 + (c >> 5), rr = r & 15, cc = c & 31, ob = rr * 64 + cc * 2; return st * 1024 + (ob ^ (((ob >> 9) & 1) << 5)); }
__host__ __device__ __forceinline__ void stage_rc(int b, int& R, int& C) { const int st = b / 1024, sb = b % 1024, swz = sb ^ (((sb >> 9) & 1) << 5); R = (st >> 1) * 16 + swz / 64; C = (st & 1) * 32 + (swz % 64) / 2; }
__host__ __device__ __forceinline__ int perm32(int rho) { const int n = rho >> 4, i = rho & 15; return 8 * (i >> 2) + 4 * n + (i & 3); }

struct Unit { int pm, pn; };
struct Gemm { const bf16_t* A; const bf16_t* Bt; int M, N, K; };

struct StaticOrder {
    int nM, nN, nwg, G, c;
    __host__ __device__ void init(int M, int N, int G_, int c_) { nM = M / BM; nN = N / BM; nwg = nM * nN; G = G_; c = c_; }
    __host__ __device__ bool next(int i, Unit& u) const {
        const long L = (long)i * G + c; if (L >= nwg) return false;
        int wgid = (int)L; { const int q = nwg / NXCD, r = nwg % NXCD, xcd = wgid % NXCD, off = wgid / NXCD; wgid = (xcd < r ? xcd * (q + 1) : r * (q + 1) + (xcd - r) * q) + off; }
        const int nig = WGM * nN, gid = wgid / nig, fm = gid * WGM, gsz = (nM - fm) < WGM ? (nM - fm) : WGM;
        u.pm = fm + ((wgid % nig) % gsz); u.pn = (wgid % nig) / gsz; return true;
    }
    __device__ __forceinline__ void a_ready(const Unit&) const {}
    __device__ __forceinline__ void done(const Unit&) const {}
};


__device__ __forceinline__ unsigned cvt_pk_bf16(float lo, float hi) { unsigned r; asm volatile("v_cvt_pk_bf16_f32 %0, %1, %2" : "=v"(r) : "v"(lo), "v"(hi)); return r; }
__device__ __forceinline__ float sigmoid_f(float g) { return __builtin_amdgcn_rcpf(1.0f + __expf(-g)); }
__device__ __forceinline__ float silu_f(float g) { return g * sigmoid_f(g); }

struct EpiSwiGLU {
    static constexpr bool PERM = true, AFTER_DRAIN = false;
    bf16_t* O; int ldc;
    __device__ __forceinline__ void operator()(const f32x4 (&acc)[2][2][4][2], const Unit& u, int wr, int wc, int fr, int fq) const {
        const int row0 = u.pm * BM + wr * 64 + fr, col0 = u.pn * HALF + wc * 32 + 8 * fq;
#pragma unroll
        for (int ai = 0; ai < 2; ++ai)
#pragma unroll
            for (int m = 0; m < 4; ++m) { bf16_t* rowp = O + (size_t)(row0 + ai * HALF + m * 16) * ldc + col0;
                const f32x4 g0 = acc[ai][0][m][0], g1 = acc[ai][0][m][1], v0 = acc[ai][1][m][0], v1 = acc[ai][1][m][1];
                f32x4 h0, h1;
#pragma unroll
                for (int e = 0; e < 4; ++e) { h0[e] = silu_f(g0[e]) * v0[e]; h1[e] = silu_f(g1[e]) * v1[e]; }
                u32x4 w; w.x = cvt_pk_bf16(h0[0], h0[1]); w.y = cvt_pk_bf16(h0[2], h0[3]); w.z = cvt_pk_bf16(h1[0], h1[1]); w.w = cvt_pk_bf16(h1[2], h1[3]);
                *(u32x4*)rowp = w; }
    }
};

struct EpiMixIn {
    static constexpr bool PERM = false, AFTER_DRAIN = false;
    float* GLU; float* ZP; const float* bias;
    __device__ __forceinline__ void operator()(const f32x4 (&acc)[2][2][4][2], const Unit& u, int wr, int wc, int fr, int fq) const {
        const int row0 = u.pm * BM + wr * 64 + fr;
        if (u.pn < 4) {
            const int cb = u.pn * HALF + wc * 32 + 4 * fq;
            f32x4 ba[2], bb[2];
#pragma unroll
            for (int n = 0; n < 2; ++n) { ba[n] = *(const f32x4*)(bias + cb + 16 * n); bb[n] = *(const f32x4*)(bias + 512 + cb + 16 * n); }
#pragma unroll
            for (int ai = 0; ai < 2; ++ai)
#pragma unroll
                for (int m = 0; m < 4; ++m) { float* rowp = GLU + (size_t)(row0 + ai * HALF + m * 16) * CC + cb;
#pragma unroll
                    for (int n = 0; n < 2; ++n) { const f32x4 za = acc[ai][0][m][n] + ba[n], zb = acc[ai][1][m][n] + bb[n]; f32x4 o;
#pragma unroll
                        for (int e = 0; e < 4; ++e) o[e] = za[e] * sigmoid_f(zb[e]);
                        *(f32x4*)(rowp + 16 * n) = o; } }
        } else {
            const int cb = (u.pn - 4) * BM + wc * 32 + 4 * fq;
            f32x4 bv[2][2];
#pragma unroll
            for (int bj = 0; bj < 2; ++bj)
#pragma unroll
                for (int n = 0; n < 2; ++n) bv[bj][n] = *(const f32x4*)(bias + 1024 + cb + bj * HALF + 16 * n);
#pragma unroll
            for (int ai = 0; ai < 2; ++ai)
#pragma unroll
                for (int m = 0; m < 4; ++m) { float* rowp = ZP + (size_t)(row0 + ai * HALF + m * 16) * PC + cb;
#pragma unroll
                    for (int bj = 0; bj < 2; ++bj)
#pragma unroll
                        for (int n = 0; n < 2; ++n) *(f32x4*)(rowp + bj * HALF + 16 * n) = acc[ai][bj][m][n] + bv[bj][n]; }
        }
    }
};

struct EpiResid {
    static constexpr bool PERM = false, AFTER_DRAIN = false;
    const float* res_p; const float* res_s; float* out; const float* gate; const float* bias; float gs;
    __device__ __forceinline__ void operator()(const f32x4 (&acc)[2][2][4][2], const Unit& u, int wr, int wc, int fr, int fq) const {
        const int c0 = u.pn * BM + wc * 32 + 4 * fq;
#pragma unroll
        for (int ai = 0; ai < 2; ++ai) {
            const int rbase = u.pm * BM + ai * HALF + wr * 64;
            const float* gp = gate + (size_t)batch_of_row(rbase) * NMOD + c0;
            f32x4 gv[2][2], bv[2][2];
#pragma unroll
            for (int bj = 0; bj < 2; ++bj)
#pragma unroll
                for (int n = 0; n < 2; ++n) { gv[bj][n] = *(const f32x4*)(gp + bj * HALF + 16 * n) * gs;
                    bv[bj][n] = bias ? *(const f32x4*)(bias + c0 + bj * HALF + 16 * n) : (f32x4){0.f, 0.f, 0.f, 0.f}; }
#pragma unroll
            for (int m = 0; m < 4; ++m) { const int r = rbase + m * 16 + fr;
                const float* rp = (r < M_P ? res_p + (size_t)r * D : res_s + (size_t)(r - M_P) * D) + c0; float* op = out + (size_t)r * D + c0;
#pragma unroll
                for (int bj = 0; bj < 2; ++bj)
#pragma unroll
                    for (int n = 0; n < 2; ++n) { const f32x4 x = *(const f32x4*)(rp + bj * HALF + 16 * n);
                        *(f32x4*)(op + bj * HALF + 16 * n) = x * ALPHA + gv[bj][n] * (acc[ai][bj][m][n] + bv[bj][n]); } }
        }
    }
};

template <class Epi, class Sched, bool ALIGN_EPI = false, bool SP2 = false>
__device__ __forceinline__ void gemm_phase(PG8_LAS unsigned char* lds, const Gemm g, const Sched& S, const Epi& E) {
    const int tid = threadIdx.x, wid = __builtin_amdgcn_readfirstlane(tid >> 6), lane = tid & 63, wr = wid >> 2, wc = wid & 3, fr = lane & 15, fq = lane >> 4;
    const int K = g.K, nt = K / BK;
    unsigned voffA[2], voffB[2];
#pragma unroll
    for (int i = 0; i < 2; ++i) { int R, C; stage_rc(tid * 16 + i * 8192, R, C); const int Rb = Epi::PERM ? ((R & ~31) + perm32(R & 31)) : R;
        voffA[i] = (unsigned)(R * K + C) * 2u; voffB[i] = (unsigned)(Rb * K + C) * 2u; }
    const size_t kstep = (size_t)(BK * 2);
    const size_t hstep = (size_t)HALF * K * 2;
    const size_t tstep = 2 * hstep;
    const unsigned ldsw = (unsigned)wid * 1024u;
    const int aoff = lds_byte(wr * 64 + fr, fq * 8), boff = lds_byte(wc * 32 + fr, fq * 8);
#define PG8_SA(b, h) (((b) * 2 + (h)) * HTB)
#define PG8_SB(b, h) ((4 + (b) * 2 + (h)) * HTB)
#define PG8_STAGE(bufoff, gbase, voff) do { _Pragma("unroll") for (int _i = 0; _i < 2; ++_i) \
        __builtin_amdgcn_global_load_lds((const unsigned*)((const char*)(gbase) + (voff)[_i]), (PG8_LAS unsigned*)(lds + (bufoff) + ldsw + _i * 8192), 16, 0, 0); } while (0)
#define PG8_LDA(dst, b, h) do { _Pragma("unroll") for (int m = 0; m < 4; ++m) _Pragma("unroll") for (int k = 0; k < 2; ++k) dst[m][k] = *(const PG8_LAS bf16x8*)(lds + PG8_SA(b, h) + aoff + m * 2048 + k * 1024); } while (0)
#define PG8_LDB(dst, b, h) do { _Pragma("unroll") for (int n = 0; n < 2; ++n) _Pragma("unroll") for (int k = 0; k < 2; ++k) dst[n][k] = *(const PG8_LAS bf16x8*)(lds + PG8_SB(b, h) + boff + n * 2048 + k * 1024); } while (0)
#define PG8_MMA(ai, bj, At, Bt) do { __builtin_amdgcn_s_setprio(1); _Pragma("unroll") for (int m = 0; m < 4; ++m) _Pragma("unroll") for (int n = 0; n < 2; ++n) _Pragma("unroll") for (int k = 0; k < 2; ++k) \
        acc[ai][bj][m][n] = __builtin_amdgcn_mfma_f32_16x16x32_bf16(Bt[n][k], At[m][k], acc[ai][bj][m][n], 0, 0, 0); __builtin_amdgcn_s_setprio(0); } while (0)
#define PG8_WAIT_V(n) asm volatile("s_waitcnt vmcnt(" #n ")" ::: "memory")
#define PG8_WAIT_L(n) asm volatile("s_waitcnt lgkmcnt(" #n ")" ::: "memory")
#define PG8_BAR __builtin_amdgcn_s_barrier()
#define PG8_SCHED __builtin_amdgcn_sched_barrier(0)
    Unit cur, nxt; int ui = 0;
    if (!S.next(0, cur)) return;
    f32x4 acc[2][2][4][2];
#pragma unroll
    for (int a = 0; a < 2; ++a)
#pragma unroll
        for (int b = 0; b < 2; ++b)
#pragma unroll
            for (int m = 0; m < 4; ++m)
#pragma unroll
                for (int n = 0; n < 2; ++n) acc[a][b][m][n] = (f32x4){0.f, 0.f, 0.f, 0.f};
    bf16x8 At[4][2], B0[2][2], B1[2][2];
    const char* cA = (const char*)g.A + (size_t)cur.pm * tstep; const char* cB = (const char*)g.Bt + (size_t)cur.pn * tstep;
    S.a_ready(cur);
    if constexpr (SP2) {
        PG8_STAGE(PG8_SB(0, 0), cB, voffB); PG8_STAGE(PG8_SB(0, 1), cB + hstep, voffB); PG8_STAGE(PG8_SA(0, 0), cA, voffA); PG8_STAGE(PG8_SA(0, 1), cA + hstep, voffA);
        if (wr == 1) PG8_BAR;
        PG8_WAIT_V(2); PG8_BAR;
        PG8_STAGE(PG8_SB(1, 0), cB + kstep, voffB); PG8_STAGE(PG8_SA(1, 0), cA + kstep, voffA); PG8_STAGE(PG8_SB(1, 1), cB + hstep + kstep, voffB);
        PG8_WAIT_V(6); PG8_BAR;
    } else {
        PG8_STAGE(PG8_SB(0, 0), cB, voffB); PG8_STAGE(PG8_SA(0, 0), cA, voffA); PG8_STAGE(PG8_SB(0, 1), cB + hstep, voffB); PG8_STAGE(PG8_SA(0, 1), cA + hstep, voffA);
        if (wr == 1) PG8_BAR;
        PG8_WAIT_V(4); PG8_BAR;
        PG8_STAGE(PG8_SB(1, 0), cB + kstep, voffB); PG8_STAGE(PG8_SA(1, 0), cA + kstep, voffA); PG8_STAGE(PG8_SB(1, 1), cB + hstep + kstep, voffB);
        PG8_WAIT_V(6); PG8_BAR;
    }
    for (;;) {
        const bool has_next = S.next(ui + 1, nxt);
        const char* nA = has_next ? (const char*)g.A + (size_t)nxt.pm * tstep : cA; const char* nB = has_next ? (const char*)g.Bt + (size_t)nxt.pn * tstep : cB;
        for (int t = 0; t < nt; t += 2) {
            const bool last = (t == nt - 2);
            const char* a1 = cA + (size_t)(t + 1) * kstep;
            const char* a2 = last ? nA : cA + (size_t)(t + 2) * kstep; const char* b2 = last ? nB : cB + (size_t)(t + 2) * kstep;
            const char* a3 = a2 + kstep; const char* b3 = b2 + kstep;
            if (last && has_next) S.a_ready(nxt);
            if constexpr (SP2) {
            PG8_LDB(B0, 0, 0); PG8_LDB(B1, 0, 1); PG8_SCHED; PG8_LDA(At, 0, 0); PG8_STAGE(PG8_SA(1, 1), a1 + hstep, voffA);
            PG8_WAIT_V(8); PG8_WAIT_L(0); PG8_BAR; PG8_MMA(0, 0, At, B0); PG8_MMA(0, 1, At, B1); PG8_BAR; PG8_SCHED;
            PG8_LDA(At, 0, 1); PG8_STAGE(PG8_SB(0, 0), b2, voffB); PG8_STAGE(PG8_SB(0, 1), b2 + hstep, voffB); PG8_STAGE(PG8_SA(0, 0), a2, voffA);
            PG8_WAIT_V(8); PG8_WAIT_L(0); PG8_BAR; PG8_MMA(1, 0, At, B0); PG8_MMA(1, 1, At, B1); PG8_BAR; PG8_SCHED;
            PG8_LDB(B0, 1, 0); PG8_LDB(B1, 1, 1); PG8_SCHED; PG8_LDA(At, 1, 0); PG8_STAGE(PG8_SA(0, 1), a2 + hstep, voffA);
            PG8_WAIT_V(8); PG8_WAIT_L(0); PG8_BAR; PG8_MMA(0, 0, At, B0); PG8_MMA(0, 1, At, B1); PG8_BAR; PG8_SCHED;
            PG8_LDA(At, 1, 1); PG8_STAGE(PG8_SB(1, 0), b3, voffB); PG8_STAGE(PG8_SB(1, 1), b3 + hstep, voffB); PG8_STAGE(PG8_SA(1, 0), a3, voffA);
            PG8_WAIT_V(8); PG8_WAIT_L(0); PG8_BAR; PG8_MMA(1, 0, At, B0); PG8_MMA(1, 1, At, B1); PG8_BAR; PG8_SCHED;
            } else {
            PG8_LDB(B0, 0, 0); PG8_SCHED; PG8_LDA(At, 0, 0); PG8_STAGE(PG8_SA(1, 1), a1 + hstep, voffA);
            PG8_WAIT_L(8); PG8_BAR; PG8_WAIT_L(0); PG8_MMA(0, 0, At, B0); PG8_BAR; PG8_SCHED;
            PG8_LDB(B1, 0, 1); PG8_STAGE(PG8_SB(0, 0), b2, voffB);
            PG8_BAR; PG8_WAIT_L(0); PG8_MMA(0, 1, At, B1); PG8_BAR;
            PG8_LDA(At, 0, 1); PG8_STAGE(PG8_SA(0, 0), a2, voffA);
            PG8_BAR; PG8_WAIT_L(0); PG8_MMA(1, 0, At, B0); PG8_BAR; PG8_SCHED;
            PG8_STAGE(PG8_SB(0, 1), b2 + hstep, voffB);
            PG8_WAIT_V(6); PG8_BAR; PG8_MMA(1, 1, At, B1); PG8_BAR;
            PG8_LDB(B0, 1, 0); PG8_SCHED; PG8_LDA(At, 1, 0); PG8_STAGE(PG8_SA(0, 1), a2 + hstep, voffA);
            PG8_WAIT_L(8); PG8_BAR; PG8_WAIT_L(0); PG8_MMA(0, 0, At, B0); PG8_BAR; PG8_SCHED;
            PG8_LDB(B1, 1, 1); PG8_STAGE(PG8_SB(1, 0), b3, voffB);
            PG8_BAR; PG8_WAIT_L(0); PG8_MMA(0, 1, At, B1); PG8_BAR;
            PG8_LDA(At, 1, 1); PG8_STAGE(PG8_SA(1, 0), a3, voffA);
            PG8_BAR; PG8_WAIT_L(0); PG8_MMA(1, 0, At, B0); PG8_BAR; PG8_SCHED;
            PG8_STAGE(PG8_SB(1, 1), b3 + hstep, voffB);
            PG8_WAIT_V(6); PG8_BAR; PG8_MMA(1, 1, At, B1); PG8_BAR;
            }
        }
        if constexpr (ALIGN_EPI) { if (wr == 0) PG8_BAR; }
        if constexpr (!Epi::AFTER_DRAIN) { E(acc, cur, wr, wc, fr, fq); S.done(cur); }
        if (!has_next) break;
#pragma unroll
        for (int a = 0; a < 2; ++a)
#pragma unroll
            for (int b = 0; b < 2; ++b)
#pragma unroll
                for (int m = 0; m < 4; ++m)
#pragma unroll
                    for (int n = 0; n < 2; ++n) acc[a][b][m][n] = (f32x4){0.f, 0.f, 0.f, 0.f};
        cur = nxt; cA = nA; cB = nB; ++ui;
        if constexpr (ALIGN_EPI) { if (wr == 1) PG8_BAR; }
    }
    PG8_WAIT_V(0);
    if constexpr (!ALIGN_EPI) { if (wr == 0) PG8_BAR; }
    PG8_BAR;
    if constexpr (Epi::AFTER_DRAIN) { E.fused(acc, cur, wr, wc, fr, fq, lds, wid, lane); S.done(cur); }
#undef PG8_SA
#undef PG8_SB
#undef PG8_STAGE
#undef PG8_LDA
#undef PG8_LDB
#undef PG8_MMA
#undef PG8_WAIT_V
#undef PG8_WAIT_L
#undef PG8_BAR
#undef PG8_SCHED
}
}

constexpr int NWAVES = 8, NTHREADS = NWAVES * 64;
constexpr int NPHASE = 12;
#ifndef MK_N_LAUNCHES
#define MK_N_LAUNCHES 1
#endif
constexpr int N_LAUNCHES = MK_N_LAUNCHES;
constexpr int RING_BYTES = 131072, LDS_BYTES = 147456;

#define GAS __attribute__((address_space(1)))
#define LAS __attribute__((address_space(3)))
typedef unsigned short bf16;
typedef unsigned v4u __attribute__((ext_vector_type(4)));
typedef unsigned v2u __attribute__((ext_vector_type(2)));
typedef float f32x4 __attribute__((ext_vector_type(4)));
#define LDS_WAIT() asm volatile("s_waitcnt lgkmcnt(0)" ::: "memory")
__device__ __forceinline__ unsigned pk2(float lo, float hi) { return pg8::cvt_pk_bf16(lo, hi); }
__device__ __forceinline__ float wave_sum(float v) {
#pragma unroll
    for (int o = 1; o < 64; o <<= 1) v += __shfl_xor(v, o);
    return v;
}

struct Args { const float* in[23]; float* out; unsigned char* ws; int ph_lo, ph_hi; };
enum { I_XP = 0, I_XS, I_CCONV, I_CPOOL, I_CP, I_CS, I_ADAW, I_ADAB, I_LNG, I_LNB, I_FWIN, I_FWDN, I_MWIN, I_MBIN, I_CONVW, I_CONVB, I_CLNG, I_CLNB, I_POOLW, I_POOLB, I_PSCALE, I_MWOUT, I_MBOUT };

__device__ __forceinline__ void transpose_item(const float* W, int ldw, bf16* WT, int ldt, int k0, int n0, int drow0, LAS float* scr, int lane) {
#pragma unroll 8
    for (int i = 0; i < 32; ++i) { const int kk = 2 * i + (lane >> 5); scr[kk * 33 + (lane & 31)] = W[(size_t)(k0 + kk) * ldw + n0 + (lane & 31)]; }
    LDS_WAIT(); asm volatile("" ::: "memory");
    const int c = lane & 7;
#pragma unroll
    for (int j = 0; j < 4; ++j) { const int n = (lane >> 3) + 8 * j; const LAS float* s = scr + (8 * c) * 33 + n;
        v4u o; o.x = pk2(s[0 * 33], s[1 * 33]); o.y = pk2(s[2 * 33], s[3 * 33]); o.z = pk2(s[4 * 33], s[5 * 33]); o.w = pk2(s[6 * 33], s[7 * 33]);
        *(v4u*)(WT + (size_t)(drow0 + n) * ldt + k0 + 8 * c) = o; }
    LDS_WAIT(); asm volatile("" ::: "memory");
}
constexpr int I_IN = (D / 64) * (2 * DFF / 32), I_DN = (DFF / 64) * (D / 32), I_MI = (D / 64) * (INC / 32), I_MO = (CC / 64) * (D / 32), I_FOLD = 64 * 16, I_B = 16;
constexpr int N_WAVE_ITEMS = 2 * I_IN + 2 * I_DN + I_MI + I_MO + I_FOLD + I_B;
static_assert(N_WAVE_ITEMS % NWAVES == 0, "wave items per block item");
constexpr int N_MOD_ITEMS = NMOD / 64, N_BLOCK_ITEMS = N_MOD_ITEMS + N_WAVE_ITEMS / NWAVES;

__device__ __forceinline__ void p0_wave_item(const Args& a, int r, LAS float* scr, int lane) {
    unsigned char* ws = a.ws;
    for (int l = 0; l < 2; ++l) { if (r < I_IN) { const int nblk = 2 * DFF / 32, kb = r / nblk, nb = r % nblk, n0 = 32 * nb, h = n0 >= DFF ? 1 : 0, j = n0 - h * DFF;
            transpose_item(a.in[I_FWIN] + (size_t)l * D * 2 * DFF, 2 * DFF, (bf16*)(ws + (l ? WS_WIN2 : WS_WIN1)), D, 64 * kb, n0, 256 * (j >> 7) + 128 * h + (j & 127), scr, lane); return; } r -= I_IN; }
    for (int l = 0; l < 2; ++l) { if (r < I_DN) { const int nblk = D / 32, kb = r / nblk, nb = r % nblk;
            transpose_item(a.in[I_FWDN] + (size_t)l * DFF * D, D, (bf16*)(ws + (l ? WS_WDN2 : WS_WDN1)), DFF, 64 * kb, 32 * nb, 32 * nb, scr, lane); return; } r -= I_DN; }
    if (r < I_MI) { const int nblk = INC / 32, kb = r / nblk, nb = r % nblk, n0 = 32 * nb; int drow = n0;
        if (n0 < 1024) { const int h = n0 >= 512 ? 1 : 0, j = n0 - 512 * h; drow = 256 * (j >> 7) + 128 * h + (j & 127); }
        transpose_item(a.in[I_MWIN], INC, (bf16*)(ws + WS_WMI), D, 64 * kb, n0, drow, scr, lane); return; } r -= I_MI;
    if (r < I_MO) { const int nblk = D / 32, kb = r / nblk, nb = r % nblk;
        transpose_item(a.in[I_MWOUT], D, (bf16*)(ws + WS_WMO), D, 64 * kb, 32 * nb, 32 * nb, scr, lane); return; } r -= I_MO;
    const float* wout = a.in[I_MWOUT]; const float* pscale = a.in[I_PSCALE];
    if (r < I_FOLD) {
        const int cg8 = r >> 4, nb = r & 15, g = cg8 >> 4, cg0 = cg8 * 8, n = nb * 64 + lane;
        const float* pw = a.in[I_POOLW] + (size_t)cg0 * 128;
        float acc[8];
#pragma unroll
        for (int e = 0; e < 8; ++e) acc[e] = 0.f;
        for (int d = 0; d < 128; ++d) { const float w = wout[(size_t)(512 + g * 128 + d) * D + n] * pscale[g * 128 + d];
#pragma unroll
            for (int e = 0; e < 8; ++e) acc[e] += pw[e * 128 + d] * w; }
        v4u o; o.x = pk2(acc[0], acc[1]); o.y = pk2(acc[2], acc[3]); o.z = pk2(acc[4], acc[5]); o.w = pk2(acc[6], acc[7]);
        *(v4u*)((bf16*)(ws + WS_WMO) + (size_t)n * D + 512 + cg0) = o; return; } r -= I_FOLD;
    {
        const int n = r * 64 + lane; const float* pb = a.in[I_POOLB]; float acc = a.in[I_MBOUT][n];
        for (int j = 0; j < PC; ++j) acc += pb[j] * pscale[j] * wout[(size_t)(512 + j) * D + n];
        ((float*)(ws + WS_BIAS2))[n] = acc; }
}
__device__ __forceinline__ void p0_mod_item(const Args& a, int item, LAS unsigned char* lds, int tid, int wave, int lane) {
    LAS float* sc = (LAS float*)lds; LAS float* red = (LAS float*)(lds + NBATCH * D * 4);
    for (int idx = tid; idx < NBATCH * D; idx += NTHREADS) { const int b = idx >> 10, k = idx & 1023; const float c = b < NB_P ? a.in[I_CP][b * D + k] : a.in[I_CS][(b - NB_P) * D + k]; sc[idx] = c / (1.0f + __expf(-c)); }
    __syncthreads();
    const int j = item * 64 + lane; const float* aw = a.in[I_ADAW] + j;
    float acc[NBATCH];
#pragma unroll
    for (int b = 0; b < NBATCH; ++b) acc[b] = 0.f;
    for (int k4 = 0; k4 < 32; ++k4) { const int kk = wave * 128 + 4 * k4;
        const float a0 = aw[(size_t)(kk + 0) * NMOD], a1 = aw[(size_t)(kk + 1) * NMOD], a2 = aw[(size_t)(kk + 2) * NMOD], a3 = aw[(size_t)(kk + 3) * NMOD];
#pragma unroll
        for (int b = 0; b < NBATCH; ++b) { const f32x4 s = *(const LAS f32x4*)(sc + b * D + kk); acc[b] += (a0 * s.x + a1 * s.y) + (a2 * s.z + a3 * s.w); } }
#pragma unroll
    for (int b = 0; b < NBATCH; ++b) red[(wave * NBATCH + b) * 64 + lane] = acc[b];
    __syncthreads();
    for (int idx = tid; idx < NBATCH * 64; idx += NTHREADS) { const int b = idx >> 6, l = idx & 63; float s = a.in[I_ADAB][item * 64 + l];
#pragma unroll
        for (int w = 0; w < NWAVES; ++w) s += red[(w * NBATCH + b) * 64 + l];
        ((float*)(a.ws + WS_MOD))[(size_t)b * NMOD + item * 64 + l] = s; }
    __syncthreads();
}

__device__ __forceinline__ void store_mod_row(const f32x4 (&v)[4], const float* MOD, int m, int kmod, bf16* U, int lane) {
    const float* mp = MOD + (size_t)batch_of_row(m) * NMOD + 3 * kmod * D; const f32x4* sh = (const f32x4*)mp + lane; const f32x4* sc = (const f32x4*)(mp + D) + lane;
    v2u* o = (v2u*)(U + (size_t)m * D) + lane;
#pragma unroll
    for (int j = 0; j < 4; ++j) { const f32x4 u = v[j] * (sc[64 * j] + 1.0f) + sh[64 * j]; v2u w; w.x = pk2(u.x, u.y); w.y = pk2(u.z, u.w); o[64 * j] = w; }
}
__device__ __forceinline__ void modulate_phase(const Args& a, int G, int wave, int lane) {
    const float* MOD = (const float*)(a.ws + WS_MOD); bf16* U = (bf16*)(a.ws + WS_U);
    for (int m = blockIdx.x * NWAVES + wave; m < M; m += G * NWAVES) {
        const f32x4* xr = (const f32x4*)(m < M_P ? a.in[I_XP] + (size_t)m * D : a.in[I_XS] + (size_t)(m - M_P) * D) + lane;
        f32x4 v[4];
#pragma unroll
        for (int j = 0; j < 4; ++j) v[j] = xr[64 * j];
        store_mod_row(v, MOD, m, 0, U, lane);
    }
}
__device__ __forceinline__ void ln_phase(const Args& a, int kln, int kmod, int G, int wave, int lane) {
    const float* MOD = (const float*)(a.ws + WS_MOD); bf16* U = (bf16*)(a.ws + WS_U); float* XY = a.out + OUT_Y;
    f32x4 gv[4], bv[4];
#pragma unroll
    for (int j = 0; j < 4; ++j) { gv[j] = ((const f32x4*)(a.in[I_LNG] + kln * D))[lane + 64 * j]; bv[j] = ((const f32x4*)(a.in[I_LNB] + kln * D))[lane + 64 * j]; }
    for (int m = blockIdx.x * NWAVES + wave; m < M; m += G * NWAVES) {
        f32x4* xr = (f32x4*)(XY + (size_t)m * D) + lane;
        f32x4 v[4]; float s = 0.f;
#pragma unroll
        for (int j = 0; j < 4; ++j) { v[j] = xr[64 * j]; s += (v[j].x + v[j].y) + (v[j].z + v[j].w); }
        const float mean = wave_sum(s) * (1.f / D); float s2 = 0.f;
#pragma unroll
        for (int j = 0; j < 4; ++j) { v[j] = v[j] - mean; s2 += (v[j].x * v[j].x + v[j].y * v[j].y) + (v[j].z * v[j].z + v[j].w * v[j].w); }
        const float rstd = 1.f / sqrtf(wave_sum(s2) * (1.f / D) + LN_EPS);
#pragma unroll
        for (int j = 0; j < 4; ++j) { v[j] = v[j] * rstd * gv[j] + bv[j]; xr[64 * j] = v[j]; }
        if (kmod >= 0) store_mod_row(v, MOD, m, kmod, U, lane);
    }
}

constexpr int CT = 32;
__device__ __forceinline__ void convpool_unit(const Args& a, int unit, LAS unsigned char* lds, int tid, int wave, int lane) {
    const float* GLU = (const float*)(a.ws + WS_GLU); const float* ZP = (const float*)(a.ws + WS_ZP); bf16* A2 = (bf16*)(a.ws + WS_U);
    LAS float* tile = (LAS float*)lds;
    const int row0 = unit * CT; const bool samp = row0 >= M_P;
    int b, t0, Tlen, rowbase;
    if (!samp) { b = row0 >> 14; t0 = row0 & (T_P - 1); Tlen = T_P; rowbase = b * T_P; }
    else { const int r = row0 - M_P; b = r >> 6; t0 = r & (T_S - 1); Tlen = T_S; rowbase = M_P + b * T_S; }
    const bool last = (t0 + CT == Tlen);
    const int c = tid;
    {
        float w[CW], acc[CT];
#pragma unroll
        for (int k = 0; k < CW; ++k) w[k] = a.in[I_CONVW][k * CC + c];
        const float cb = a.in[I_CONVB][c];
#pragma unroll
        for (int tt = 0; tt < CT; ++tt) acc[tt] = cb;
        float* st = a.out + (samp ? OUT_SCS : OUT_SCP) + (size_t)b * CH * CC + c;
#pragma unroll
        for (int i = 0; i < CT + CH; ++i) { const int ti = t0 - CH + i; float val = 0.f;
            if (ti >= 0) val = GLU[(size_t)(rowbase + ti) * CC + c]; else if (samp) val = a.in[I_CCONV][(size_t)(b * CH + CH + ti) * CC + c];
            if (i >= CT && last) st[(size_t)(i - CT) * CC] = val;
#pragma unroll
            for (int tt = 0; tt < CT; ++tt) { const int k = i - tt; if (k >= 0 && k < CW) acc[tt] += w[k] * val; } }
#pragma unroll
        for (int tt = 0; tt < CT; ++tt) tile[tt * CC + c] = acc[tt];
    }
    {
        const int g = c >> 7, wnd = 2 << g;
        float in[CT + PH];
        float* st = a.out + (samp ? OUT_SPS : OUT_SPP) + (size_t)b * PH * PC + c;
#pragma unroll
        for (int i = 0; i < CT + PH; ++i) { const int ti = t0 - PH + i; float val = 0.f;
            if (ti >= 0) val = ZP[(size_t)(rowbase + ti) * PC + c]; else if (samp) val = a.in[I_CPOOL][(size_t)(b * PH + PH + ti) * PC + c];
            if (i >= CT && last) st[(size_t)(i - CT) * PC] = val;
            in[i] = val; }
        float s2[CT + PH], s4[CT + PH], s8[CT + PH], s16[CT + PH];
#pragma unroll
        for (int i = 0; i < CT + PH; ++i) { s2[i] = in[i] + (i >= 1 ? in[i - 1] : 0.f); }
#pragma unroll
        for (int i = 0; i < CT + PH; ++i) { s4[i] = s2[i] + (i >= 2 ? s2[i - 2] : 0.f); }
#pragma unroll
        for (int i = 0; i < CT + PH; ++i) { s8[i] = s4[i] + (i >= 4 ? s4[i - 4] : 0.f); }
#pragma unroll
        for (int i = 0; i < CT + PH; ++i) { s16[i] = s8[i] + (i >= 8 ? s8[i - 8] : 0.f); }
        bf16* op = A2 + (size_t)row0 * D + 512 + c;
#pragma unroll
        for (int tt = 0; tt < CT; ++tt) { const int i = PH + tt; const float wsum = g == 0 ? s2[i] : g == 1 ? s4[i] : g == 2 ? s8[i] : s16[i];
            const int pos = (samp ? PAST : 0) + t0 + tt; const int cnt = pos + 1 < wnd ? pos + 1 : wnd;
            const float pooled = wsum / (float)cnt - in[i];
            op[(size_t)tt * D] = (bf16)(pk2(pooled, 0.f) & 0xffffu); }
    }
    __syncthreads();
    {
        const f32x4 g0 = ((const f32x4*)a.in[I_CLNG])[lane], g1 = ((const f32x4*)a.in[I_CLNG])[64 + lane], b0 = ((const f32x4*)a.in[I_CLNB])[lane], b1 = ((const f32x4*)a.in[I_CLNB])[64 + lane];
#pragma unroll
        for (int q = 0; q < CT / NWAVES; ++q) { const int tt = wave * (CT / NWAVES) + q;
            f32x4 v0 = *(const LAS f32x4*)(tile + tt * CC + 4 * lane), v1 = *(const LAS f32x4*)(tile + tt * CC + 256 + 4 * lane);
            const float mean = wave_sum((v0.x + v0.y) + (v0.z + v0.w) + (v1.x + v1.y) + (v1.z + v1.w)) * (1.f / CC);
            v0 = v0 - mean; v1 = v1 - mean;
            const float var = wave_sum((v0.x * v0.x + v0.y * v0.y) + (v0.z * v0.z + v0.w * v0.w) + (v1.x * v1.x + v1.y * v1.y) + (v1.z * v1.z + v1.w * v1.w)) * (1.f / CC);
            const float rstd = 1.f / sqrtf(var + LN_EPS);
            v0 = v0 * rstd * g0 + b0; v1 = v1 * rstd * g1 + b1;
            v2u w0, w1; w0.x = pk2(pg8::silu_f(v0.x), pg8::silu_f(v0.y)); w0.y = pk2(pg8::silu_f(v0.z), pg8::silu_f(v0.w));
            w1.x = pk2(pg8::silu_f(v1.x), pg8::silu_f(v1.y)); w1.y = pk2(pg8::silu_f(v1.z), pg8::silu_f(v1.w));
            bf16* op = A2 + (size_t)(row0 + tt) * D;
            *(v2u*)(op + 4 * lane) = w0; *(v2u*)(op + 256 + 4 * lane) = w1; }
    }
    __syncthreads();
}

__global__ void __launch_bounds__(NTHREADS, 2) mk_fwd(Args a) {
    extern __shared__ __attribute__((aligned(16))) unsigned char lds_raw[];
    LAS unsigned char* lds = (LAS unsigned char*)lds_raw;
    const int tid = threadIdx.x, lane = tid & 63, wave = __builtin_amdgcn_readfirstlane(tid >> 6), G = gridDim.x;
    const int lo = a.ph_lo, hi = a.ph_hi;
    unsigned char* ws = a.ws;
    const float* MOD = (const float*)(ws + WS_MOD);
    bf16* U = (bf16*)(ws + WS_U); bf16* ACT = (bf16*)(ws + WS_ACT);
    float* XY = a.out + OUT_Y;
#define IN(k) (lo <= (k) && (k) < hi)
#define SEAM(k) do { if (IN(k) && IN((k) + 1)) cg::this_grid().sync(); } while (0)

    if (IN(0)) {
        for (int bi = blockIdx.x; bi < N_BLOCK_ITEMS; bi += G) {
            if (bi < N_MOD_ITEMS) p0_mod_item(a, bi, lds, tid, wave, lane);
            else p0_wave_item(a, (bi - N_MOD_ITEMS) * NWAVES + wave, (LAS float*)(lds + wave * 16384), lane);
        }
    }
    SEAM(0);
    if (IN(1)) modulate_phase(a, G, wave, lane);
    SEAM(1);
    if (IN(2)) { pg8::Gemm g{U, (const bf16*)(ws + WS_WIN1), M, 2 * DFF, D}; pg8::StaticOrder S; S.init(M, 2 * DFF, G, (int)blockIdx.x);
        pg8::EpiSwiGLU E{ACT, DFF}; pg8::gemm_phase<pg8::EpiSwiGLU, pg8::StaticOrder, true, true>(lds, g, S, E); }
    SEAM(2);
    if (IN(3)) { pg8::Gemm g{ACT, (const bf16*)(ws + WS_WDN1), M, D, DFF}; pg8::StaticOrder S; S.init(M, D, G, (int)blockIdx.x);
        pg8::EpiResid E{a.in[I_XP], a.in[I_XS], XY, MOD + 2 * D, nullptr, 0.5f}; pg8::gemm_phase<pg8::EpiResid, pg8::StaticOrder, true, true>(lds, g, S, E); }
    SEAM(3);
    if (IN(4)) ln_phase(a, 0, 1, G, wave, lane);
    SEAM(4);
    if (IN(5)) { pg8::Gemm g{U, (const bf16*)(ws + WS_WMI), M, INC, D}; pg8::StaticOrder S; S.init(M, INC, G, (int)blockIdx.x);
        pg8::EpiMixIn E{(float*)(ws + WS_GLU), (float*)(ws + WS_ZP), a.in[I_MBIN]}; pg8::gemm_phase<pg8::EpiMixIn, pg8::StaticOrder, true, true>(lds, g, S, E); }
    SEAM(5);
    if (IN(6)) { for (int u = blockIdx.x; u < M / CT; u += G) convpool_unit(a, u, lds, tid, wave, lane); }
    SEAM(6);
    if (IN(7)) { pg8::Gemm g{U, (const bf16*)(ws + WS_WMO), M, D, D}; pg8::StaticOrder S; S.init(M, D, G, (int)blockIdx.x);
        pg8::EpiResid E{XY, XY + (size_t)M_P * D, XY, MOD + 5 * D, (const float*)(ws + WS_BIAS2), 1.0f}; pg8::gemm_phase<pg8::EpiResid, pg8::StaticOrder, true, true>(lds, g, S, E); }
    SEAM(7);
    if (IN(8)) ln_phase(a, 1, 2, G, wave, lane);
    SEAM(8);
    if (IN(9)) { pg8::Gemm g{U, (const bf16*)(ws + WS_WIN2), M, 2 * DFF, D}; pg8::StaticOrder S; S.init(M, 2 * DFF, G, (int)blockIdx.x);
        pg8::EpiSwiGLU E{ACT, DFF}; pg8::gemm_phase<pg8::EpiSwiGLU, pg8::StaticOrder, true, true>(lds, g, S, E); }
    SEAM(9);
    if (IN(10)) { pg8::Gemm g{ACT, (const bf16*)(ws + WS_WDN2), M, D, DFF}; pg8::StaticOrder S; S.init(M, D, G, (int)blockIdx.x);
        pg8::EpiResid E{XY, XY + (size_t)M_P * D, XY, MOD + 8 * D, nullptr, 0.5f}; pg8::gemm_phase<pg8::EpiResid, pg8::StaticOrder, true, true>(lds, g, S, E); }
    SEAM(10);
    if (IN(11)) ln_phase(a, 2, -1, G, wave, lane);
#undef IN
#undef SEAM
}

extern "C" void kernel_launch(void* const* d_in, const int* in_sizes, int n_in, void* d_out, int out_size, void* d_ws, size_t ws_size, hipStream_t stream) {
    static int grid = 0;
    if (grid == 0) {
        if (n_in != 23 || in_sizes[0] != M_P * D || in_sizes[1] != M_S * D || (size_t)out_size != OUT_END || ws_size < WS_END) {
            fprintf(stderr, "kernel_launch: unexpected shapes (n_in %d, in0 %d, out %d, ws %zu); nothing launched\n", n_in, n_in > 0 ? in_sizes[0] : -1, out_size, ws_size); grid = -1; return; }
        int dev = 0, cus = 0, per_cu = 0;
        if (hipGetDevice(&dev) != hipSuccess || hipDeviceGetAttribute(&cus, hipDeviceAttributeMultiprocessorCount, dev) != hipSuccess) { fprintf(stderr, "kernel_launch: device query failed\n"); grid = -1; return; }
        if (hipFuncSetAttribute((const void*)mk_fwd, hipFuncAttributeMaxDynamicSharedMemorySize, LDS_BYTES) != hipSuccess) { fprintf(stderr, "kernel_launch: hipFuncSetAttribute failed\n"); grid = -1; return; }
        if (hipOccupancyMaxActiveBlocksPerMultiprocessor(&per_cu, (const void*)mk_fwd, NTHREADS, LDS_BYTES) != hipSuccess || per_cu < 1) { per_cu = 1; (void)hipGetLastError(); }
        grid = cus * per_cu;
    }
    if (grid < 0) return;
    Args a{};
    for (int i = 0; i < 23; ++i) a.in[i] = (const float*)d_in[i];
    a.out = (float*)d_out; a.ws = (unsigned char*)d_ws;
    if (N_LAUNCHES == 1) {
        a.ph_lo = 0; a.ph_hi = NPHASE;
        void* kargs[] = {&a};
        const hipError_t e = hipLaunchCooperativeKernel((const void*)mk_fwd, dim3(grid), dim3(NTHREADS), kargs, LDS_BYTES, stream);
        if (e != hipSuccess) fprintf(stderr, "kernel_launch: cooperative launch failed: %s (grid %d)\n", hipGetErrorString(e), grid);
    } else {
        for (int p = 0; p < NPHASE; ++p) { a.ph_lo = p; a.ph_hi = p + 1; hipLaunchKernelGGL(mk_fwd, dim3(grid), dim3(NTHREADS), LDS_BYTES, stream, a); }
    }
}
```

```cpp
#include <hip/hip_runtime.h>
#include <hip/hip_cooperative_groups.h>
#include <cstdio>
#include <cstdint>
namespace cg = cooperative_groups;

constexpr int D = 1024, DFF = 2816, T_P = 16384, NB_P = 2, T_S = 64, NB_S = 16;
constexpr int M_P = NB_P * T_P, M_S = NB_S * T_S, M = M_P + M_S;
constexpr int NBATCH = NB_P + NB_S, NMOD = 9 * D;
constexpr int CC = 512, PC = 512, INC = 1536, CW = 31, CH = 30, PH = 15, PAST = 4096;
constexpr float LN_EPS = 1e-5f;
constexpr float ALPHA = 1.189207115002721f;
constexpr size_t OUT_Y = 0, OUT_SCP = (size_t)M * D, OUT_SPP = OUT_SCP + (size_t)NB_P * CH * CC, OUT_SCS = OUT_SPP + (size_t)NB_P * PH * PC,
                 OUT_SPS = OUT_SCS + (size_t)NB_S * CH * CC, OUT_END = OUT_SPS + (size_t)NB_S * PH * PC;
constexpr size_t MiB = 1u << 20;
constexpr size_t WS_CTL = 0, WS_MOD = 1 * MiB, WS_BIAS2 = 1 * MiB + 768 * 1024;
constexpr size_t WS_WIN1 = 2 * MiB, WS_WIN2 = 13 * MiB, WS_WDN1 = 24 * MiB, WS_WDN2 = 30 * MiB, WS_WMI = 36 * MiB, WS_WMO = 39 * MiB;
constexpr size_t WS_U = 48 * MiB;
constexpr size_t WS_ACT = 114 * MiB;
constexpr size_t WS_GLU = WS_ACT, WS_ZP = WS_ACT + 66 * MiB;
constexpr size_t WS_END = 296 * MiB;
static_assert((size_t)NBATCH * NMOD * 4 <= 768 * 1024, "mod");
static_assert(WS_U + (size_t)M * D * 2 <= WS_ACT && WS_ACT + (size_t)M * DFF * 2 <= WS_END && WS_ZP + (size_t)M * PC * 4 <= WS_END, "ws map");
static_assert((size_t)M * CC * 4 == 66 * MiB, "glu size");

__device__ __forceinline__ int batch_of_row(int r) { return r < M_P ? (r >> 14) : NB_P + ((r - M_P) >> 6); }

namespace pg8 {
#define PG8_LAS __attribute__((address_space(3)))
typedef unsigned short bf16_t;
typedef short bf16x8 __attribute__((ext_vector_type(8)));
typedef float f32x4 __attribute__((ext_vector_type(4)));
typedef unsigned u32x4 __attribute__((ext_vector_type(4)));
constexpr int BM = 256, BK = 64, HALF = 128, HTB = HALF * BK * 2  , STAGE_BYTES = 8 * HTB, NXCD = 8, WGM = 8;

__host__ __device__ __forceinline__ int lds_byte(int r, int c) { const int st = (r >> 4) * 2 + (c >> 5), rr = r & 15, cc = c & 31, ob = rr * 64 + cc * 2; return st * 1024 + (ob ^ (((ob >> 9) & 1) << 5)); }
__host__ __device__ __forceinline__ void stage_rc(int b, int& R, int& C) { const int st = b / 1024, sb = b % 1024, swz = sb ^ (((sb >> 9) & 1) << 5); R = (st >> 1) * 16 + swz / 64; C = (st & 1) * 32 + (swz % 64) / 2; }
__host__ __device__ __forceinline__ int perm32(int rho) { const int n = rho >> 4, i = rho & 15; return 8 * (i >> 2) + 4 * n + (i & 3); }

struct Unit { int pm, pn; };
struct Gemm { const bf16_t* A; const bf16_t* Bt; int M, N, K; };

struct StaticOrder {
    int nM, nN, nwg, G, c;
    __host__ __device__ void init(int M, int N, int G_, int c_) { nM = M / BM; nN = N / BM; nwg = nM * nN; G = G_; c = c_; }
    __host__ __device__ bool next(int i, Unit& u) const {
        const long L = (long)i * G + c; if (L >= nwg) return false;
        int wgid = (int)L; { const int q = nwg / NXCD, r = nwg % NXCD, xcd = wgid % NXCD, off = wgid / NXCD; wgid = (xcd < r ? xcd * (q + 1) : r * (q + 1) + (xcd - r) * q) + off; }
        const int nig = WGM * nN, gid = wgid / nig, fm = gid * WGM, gsz = (nM - fm) < WGM ? (nM - fm) : WGM;
        u.pm = fm + ((wgid % nig) % gsz); u.pn = (wgid % nig) / gsz; return true;
    }
    __device__ __forceinline__ void a_ready(const Unit&) const {}
    __device__ __forceinline__ void done(const Unit&) const {}
};


__device__ __forceinline__ unsigned cvt_pk_bf16(float lo, float hi) { unsigned r; asm volatile("v_cvt_pk_bf16_f32 %0, %1, %2" : "=v"(r) : "v"(lo), "v"(hi)); return r; }
__device__ __forceinline__ float sigmoid_f(float g) { return __builtin_amdgcn_rcpf(1.0f + __expf(-g)); }
__device__ __forceinline__ float silu_f(float g) { return g * sigmoid_f(g); }

struct EpiSwiGLU {
    static constexpr bool PERM = true, AFTER_DRAIN = false;
    bf16_t* O; int ldc;
    __device__ __forceinline__ void operator()(const f32x4 (&acc)[2][2][4][2], const Unit& u, int wr, int wc, int fr, int fq) const {
        const int row0 = u.pm * BM + wr * 64 + fr, col0 = u.pn * HALF + wc * 32 + 8 * fq;
#pragma unroll
        for (int ai = 0; ai < 2; ++ai)
#pragma unroll
            for (int m = 0; m < 4; ++m) { bf16_t* rowp = O + (size_t)(row0 + ai * HALF + m * 16) * ldc + col0;
                const f32x4 g0 = acc[ai][0][m][0], g1 = acc[ai][0][m][1], v0 = acc[ai][1][m][0], v1 = acc[ai][1][m][1];
                f32x4 h0, h1;
#pragma unroll
                for (int e = 0; e < 4; ++e) { h0[e] = silu_f(g0[e]) * v0[e]; h1[e] = silu_f(g1[e]) * v1[e]; }
                u32x4 w; w.x = cvt_pk_bf16(h0[0], h0[1]); w.y = cvt_pk_bf16(h0[2], h0[3]); w.z = cvt_pk_bf16(h1[0], h1[1]); w.w = cvt_pk_bf16(h1[2], h1[3]);
                *(u32x4*)rowp = w; }
    }
};

struct EpiMixIn {
    static constexpr bool PERM = false, AFTER_DRAIN = false;
    float* GLU; float* ZP; const float* bias;
    __device__ __forceinline__ void operator()(const f32x4 (&acc)[2][2][4][2], const Unit& u, int wr, int wc, int fr, int fq) const {
        const int row0 = u.pm * BM + wr * 64 + fr;
        if (u.pn < 4) {
            const int cb = u.pn * HALF + wc * 32 + 4 * fq;
            f32x4 ba[2], bb[2];
#pragma unroll
            for (int n = 0; n < 2; ++n) { ba[n] = *(const f32x4*)(bias + cb + 16 * n); bb[n] = *(const f32x4*)(bias + 512 + cb + 16 * n); }
#pragma unroll
            for (int ai = 0; ai < 2; ++ai)
#pragma unroll
                for (int m = 0; m < 4; ++m) { float* rowp = GLU + (size_t)(row0 + ai * HALF + m * 16) * CC + cb;
#pragma unroll
                    for (int n = 0; n < 2; ++n) { const f32x4 za = acc[ai][0][m][n] + ba[n], zb = acc[ai][1][m][n] + bb[n]; f32x4 o;
#pragma unroll
                        for (int e = 0; e < 4; ++e) o[e] = za[e] * sigmoid_f(zb[e]);
                        *(f32x4*)(rowp + 16 * n) = o; } }
        } else {
            const int cb = (u.pn - 4) * BM + wc * 32 + 4 * fq;
            f32x4 bv[2][2];
#pragma unroll
            for (int bj = 0; bj < 2; ++bj)
#pragma unroll
                for (int n = 0; n < 2; ++n) bv[bj][n] = *(const f32x4*)(bias + 1024 + cb + bj * HALF + 16 * n);
#pragma unroll
            for (int ai = 0; ai < 2; ++ai)
#pragma unroll
                for (int m = 0; m < 4; ++m) { float* rowp = ZP + (size_t)(row0 + ai * HALF + m * 16) * PC + cb;
#pragma unroll
                    for (int bj = 0; bj < 2; ++bj)
#pragma unroll
                        for (int n = 0; n < 2; ++n) *(f32x4*)(rowp + bj * HALF + 16 * n) = acc[ai][bj][m][n] + bv[bj][n]; }
        }
    }
};

struct EpiResid {
    static constexpr bool PERM = false, AFTER_DRAIN = false;
    const float* res_p; const float* res_s; float* out; const float* gate; const float* bias; float gs;
    __device__ __forceinline__ void operator()(const f32x4 (&acc)[2][2][4][2], const Unit& u, int wr, int wc, int fr, int fq) const {
        const int c0 = u.pn * BM + wc * 32 + 4 * fq;
#pragma unroll
        for (int ai = 0; ai < 2; ++ai) {
            const int rbase = u.pm * BM + ai * HALF + wr * 64;
            const float* gp = gate + (size_t)batch_of_row(rbase) * NMOD + c0;
            f32x4 gv[2][2], bv[2][2];
#pragma unroll
            for (int bj = 0; bj < 2; ++bj)
#pragma unroll
                for (int n = 0; n < 2; ++n) { gv[bj][n] = *(const f32x4*)(gp + bj * HALF + 16 * n) * gs;
                    bv[bj][n] = bias ? *(const f32x4*)(bias + c0 + bj * HALF + 16 * n) : (f32x4){0.f, 0.f, 0.f, 0.f}; }
#pragma unroll
            for (int m = 0; m < 4; ++m) { const int r = rbase + m * 16 + fr;
                const float* rp = (r < M_P ? res_p + (size_t)r * D : res_s + (size_t)(r - M_P) * D) + c0; float* op = out + (size_t)r * D + c0;
#pragma unroll
                for (int bj = 0; bj < 2; ++bj)
#pragma unroll
                    for (int n = 0; n < 2; ++n) { const f32x4 x = *(const f32x4*)(rp + bj * HALF + 16 * n);
                        *(f32x4*)(op + bj * HALF + 16 * n) = x * ALPHA + gv[bj][n] * (acc[ai][bj][m][n] + bv[bj][n]); } }
        }
    }
};

template <class Epi, class Sched, bool ALIGN_EPI = false, bool SP2 = false>
__device__ __forceinline__ void gemm_phase(PG8_LAS unsigned char* lds, const Gemm g, const Sched& S, const Epi& E) {
    const int tid = threadIdx.x, wid = __builtin_amdgcn_readfirstlane(tid >> 6), lane = tid & 63, wr = wid >> 2, wc = wid & 3, fr = lane & 15, fq = lane >> 4;
    const int K = g.K, nt = K / BK;
    unsigned voffA[2], voffB[2];
#pragma unroll
    for (int i = 0; i < 2; ++i) { int R, C; stage_rc(tid * 16 + i * 8192, R, C); const int Rb = Epi::PERM ? ((R & ~31) + perm32(R & 31)) : R;
        voffA[i] = (unsigned)(R * K + C) * 2u; voffB[i] = (unsigned)(Rb * K + C) * 2u; }
    const size_t kstep = (size_t)(BK * 2);
    const size_t hstep = (size_t)HALF * K * 2;
    const size_t tstep = 2 * hstep;
    const unsigned ldsw = (unsigned)wid * 1024u;
    const int aoff = lds_byte(wr * 64 + fr, fq * 8), boff = lds_byte(wc * 32 + fr, fq * 8);
#define PG8_SA(b, h) (((b) * 2 + (h)) * HTB)
#define PG8_SB(b, h) ((4 + (b) * 2 + (h)) * HTB)
#define PG8_STAGE(bufoff, gbase, voff) do { _Pragma("unroll") for (int _i = 0; _i < 2; ++_i) \
        __builtin_amdgcn_global_load_lds((const unsigned*)((const char*)(gbase) + (voff)[_i]), (PG8_LAS unsigned*)(lds + (bufoff) + ldsw + _i * 8192), 16, 0, 0); } while (0)
#define PG8_LDA(dst, b, h) do { _Pragma("unroll") for (int m = 0; m < 4; ++m) _Pragma("unroll") for (int k = 0; k < 2; ++k) dst[m][k] = *(const PG8_LAS bf16x8*)(lds + PG8_SA(b, h) + aoff + m * 2048 + k * 1024); } while (0)
#define PG8_LDB(dst, b, h) do { _Pragma("unroll") for (int n = 0; n < 2; ++n) _Pragma("unroll") for (int k = 0; k < 2; ++k) dst[n][k] = *(const PG8_LAS bf16x8*)(lds + PG8_SB(b, h) + boff + n * 2048 + k * 1024); } while (0)
#define PG8_MMA(ai, bj, At, Bt) do { __builtin_amdgcn_s_setprio(1); _Pragma("unroll") for (int m = 0; m < 4; ++m) _Pragma("unroll") for (int n = 0; n < 2; ++n) _Pragma("unroll") for (int k = 0; k < 2; ++k) \
        acc[ai][bj][m][n] = __builtin_amdgcn_mfma_f32_16x16x32_bf16(Bt[n][k], At[m][k], acc[ai][bj][m][n], 0, 0, 0); __builtin_amdgcn_s_setprio(0); } while (0)
#define PG8_WAIT_V(n) asm volatile("s_waitcnt vmcnt(" #n ")" ::: "memory")
#define PG8_WAIT_L(n) asm volatile("s_waitcnt lgkmcnt(" #n ")" ::: "memory")
#define PG8_BAR __builtin_amdgcn_s_barrier()
#define PG8_SCHED __builtin_amdgcn_sched_barrier(0)
    Unit cur, nxt; int ui = 0;
    if (!S.next(0, cur)) return;
    f32x4 acc[2][2][4][2];
#pragma unroll
    for (int a = 0; a < 2; ++a)
#pragma unroll
        for (int b = 0; b < 2; ++b)
#pragma unroll
            for (int m = 0; m < 4; ++m)
#pragma unroll
                for (int n = 0; n < 2; ++n) acc[a][b][m][n] = (f32x4){0.f, 0.f, 0.f, 0.f};
    bf16x8 At[4][2], B0[2][2], B1[2][2];
    const char* cA = (const char*)g.A + (size_t)cur.pm * tstep; const char* cB = (const char*)g.Bt + (size_t)cur.pn * tstep;
    S.a_ready(cur);
    if constexpr (SP2) {
        PG8_STAGE(PG8_SB(0, 0), cB, voffB); PG8_STAGE(PG8_SB(0, 1), cB + hstep, voffB); PG8_STAGE(PG8_SA(0, 0), cA, voffA); PG8_STAGE(PG8_SA(0, 1), cA + hstep, voffA);
        if (wr == 1) PG8_BAR;
        PG8_WAIT_V(2); PG8_BAR;
        PG8_STAGE(PG8_SB(1, 0), cB + kstep, voffB); PG8_STAGE(PG8_SA(1, 0), cA + kstep, voffA); PG8_STAGE(PG8_SB(1, 1), cB + hstep + kstep, voffB);
        PG8_WAIT_V(6); PG8_BAR;
    } else {
        PG8_STAGE(PG8_SB(0, 0), cB, voffB); PG8_STAGE(PG8_SA(0, 0), cA, voffA); PG8_STAGE(PG8_SB(0, 1), cB + hstep, voffB); PG8_STAGE(PG8_SA(0, 1), cA + hstep, voffA);
        if (wr == 1) PG8_BAR;
        PG8_WAIT_V(4); PG8_BAR;
        PG8_STAGE(PG8_SB(1, 0), cB + kstep, voffB); PG8_STAGE(PG8_SA(1, 0), cA + kstep, voffA); PG8_STAGE(PG8_SB(1, 1), cB + hstep + kstep, voffB);
        PG8_WAIT_V(6); PG8_BAR;
    }
    for (;;) {
        const bool has_next = S.next(ui + 1, nxt);
        const char* nA = has_next ? (const char*)g.A + (size_t)nxt.pm * tstep : cA; const char* nB = has_next ? (const char*)g.Bt + (size_t)nxt.pn * tstep : cB;
        for (int t = 0; t < nt; t += 2) {
            const bool last = (t == nt - 2);
            const char* a1 = cA + (size_t)(t + 1) * kstep;
            const char* a2 = last ? nA : cA + (size_t)(t + 2) * kstep; const char* b2 = last ? nB : cB + (size_t)(t + 2) * kstep;
            const char* a3 = a2 + kstep; const char* b3 = b2 + kstep;
            if (last && has_next) S.a_ready(nxt);
            if constexpr (SP2) {
            PG8_LDB(B0, 0, 0); PG8_LDB(B1, 0, 1); PG8_SCHED; PG8_LDA(At, 0, 0); PG8_STAGE(PG8_SA(1, 1), a1 + hstep, voffA);
            PG8_WAIT_V(8); PG8_WAIT_L(0); PG8_BAR; PG8_MMA(0, 0, At, B0); PG8_MMA(0, 1, At, B1); PG8_BAR; PG8_SCHED;
            PG8_LDA(At, 0, 1); PG8_STAGE(PG8_SB(0, 0), b2, voffB); PG8_STAGE(PG8_SB(0, 1), b2 + hstep, voffB); PG8_STAGE(PG8_SA(0, 0), a2, voffA);
            PG8_WAIT_V(8); PG8_WAIT_L(0); PG8_BAR; PG8_MMA(1, 0, At, B0); PG8_MMA(1, 1, At, B1); PG8_BAR; PG8_SCHED;
            PG8_LDB(B0, 1, 0); PG8_LDB(B1, 1, 1); PG8_SCHED; PG8_LDA(At, 1, 0); PG8_STAGE(PG8_SA(0, 1), a2 + hstep, voffA);
            PG8_WAIT_V(8); PG8_WAIT_L(0); PG8_BAR; PG8_MMA(0, 0, At, B0); PG8_MMA(0, 1, At, B1); PG8_BAR; PG8_SCHED;
            PG8_LDA(At, 1, 1); PG8_STAGE(PG8_SB(1, 0), b3, voffB); PG8_STAGE(PG8_SB(1, 1), b3 + hstep, voffB); PG8_STAGE(PG8_SA(1, 0), a3, voffA);
            PG8_WAIT_V(8); PG8_WAIT_L(0); PG8_BAR; PG8_MMA(1, 0, At, B0); PG8_MMA(1, 1, At, B1); PG8_BAR; PG8_SCHED;
            } else {
            PG8_LDB(B0, 0, 0); PG8_SCHED; PG8_LDA(At, 0, 0); PG8_STAGE(PG8_SA(1, 1), a1 + hstep, voffA);
            PG8_WAIT_L(8); PG8_BAR; PG8_WAIT_L(0); PG8_MMA(0, 0, At, B0); PG8_BAR; PG8_SCHED;
            PG8_LDB(B1, 0, 1); PG8_STAGE(PG8_SB(0, 0), b2, voffB);
            PG8_BAR; PG8_WAIT_L(0); PG8_MMA(0, 1, At, B1); PG8_BAR;
            PG8_LDA(At, 0, 1); PG8_STAGE(PG8_SA(0, 0), a2, voffA);
            PG8_BAR; PG8_WAIT_L(0); PG8_MMA(1, 0, At, B0); PG8_BAR; PG8_SCHED;
            PG8_STAGE(PG8_SB(0, 1), b2 + hstep, voffB);
            PG8_WAIT_V(6); PG8_BAR; PG8_MMA(1, 1, At, B1); PG8_BAR;
            PG8_LDB(B0, 1, 0); PG8_SCHED; PG8_LDA(At, 1, 0); PG8_STAGE(PG8_SA(0, 1), a2 + hstep, voffA);
            PG8_WAIT_L(8); PG8_BAR; PG8_WAIT_L(0); PG8_MMA(0, 0, At, B0); PG8_BAR; PG8_SCHED;
            PG8_LDB(B1, 1, 1); PG8_STAGE(PG8_SB(1, 0), b3, voffB);
            PG8_BAR; PG8_WAIT_L(0); PG8_MMA(0, 1, At, B1); PG8_BAR;
            PG8_LDA(At, 1, 1); PG8_STAGE(PG8_SA(1, 0), a3, voffA);
            PG8_BAR; PG8_WAIT_L(0); PG8_MMA(1, 0, At, B0); PG8_BAR; PG8_SCHED;
            PG8_STAGE(PG8_SB(1, 1), b3 + hstep, voffB);
            PG8_WAIT_V(6); PG8_BAR; PG8_MMA(1, 1, At, B1); PG8_BAR;
            }
        }
        if constexpr (ALIGN_EPI) { if (wr == 0) PG8_BAR; }
        if constexpr (!Epi::AFTER_DRAIN) { E(acc, cur, wr, wc, fr, fq); S.done(cur); }
        if (!has_next) break;
#pragma unroll
        for (int a = 0; a < 2; ++a)
#pragma unroll
            for (int b = 0; b < 2; ++b)
#pragma unroll
                for (int m = 0; m < 4; ++m)
#pragma unroll
                    for (int n = 0; n < 2; ++n) acc[a][b][m][n] = (f32x4){0.f, 0.f, 0.f, 0.f};
        cur = nxt; cA = nA; cB = nB; ++ui;
        if constexpr (ALIGN_EPI) { if (wr == 1) PG8_BAR; }
    }
    PG8_WAIT_V(0);
    if constexpr (!ALIGN_EPI) { if (wr == 0) PG8_BAR; }
    PG8_BAR;
    if constexpr (Epi::AFTER_DRAIN) { E.fused(acc, cur, wr, wc, fr, fq, lds, wid, lane); S.done(cur); }
#undef PG8_SA
#undef PG8_SB
#undef PG8_STAGE
#undef PG8_LDA
#undef PG8_LDB
#undef PG8_MMA
#undef PG8_WAIT_V
#undef PG8_WAIT_L
#undef PG8_BAR
#undef PG8_SCHED
}
}

constexpr int NWAVES = 8, NTHREADS = NWAVES * 64;
constexpr int NPHASE = 12;
#ifndef MK_N_LAUNCHES
#define MK_N_LAUNCHES 1
#endif
constexpr int N_LAUNCHES = MK_N_LAUNCHES;
constexpr int RING_BYTES = 131072, LDS_BYTES = 147456;

#define GAS __attribute__((address_space(1)))
#define LAS __attribute__((address_space(3)))
typedef unsigned short bf16;
typedef unsigned v4u __attribute__((ext_vector_type(4)));
typedef unsigned v2u __attribute__((ext_vector_type(2)));
typedef float f32x4 __attribute__((ext_vector_type(4)));
#define LDS_WAIT() asm volatile("s_waitcnt lgkmcnt(0)" ::: "memory")
__device__ __forceinline__ unsigned pk2(float lo, float hi) { return pg8::cvt_pk_bf16(lo, hi); }
__device__ __forceinline__ float wave_sum(float v) {
#pragma unroll
    for (int o = 1; o < 64; o <<= 1) v += __shfl_xor(v, o);
    return v;
}

typedef GAS unsigned gu32;
#define RLX_AGENT __ATOMIC_RELAXED, __HIP_MEMORY_SCOPE_AGENT
#define VM_WAIT() asm volatile("s_waitcnt vmcnt(0)" ::: "memory")
__device__ __forceinline__ unsigned long long rt() { return __builtin_amdgcn_s_memrealtime(); }

#define XB_TMO      128
#define XB_XCNT(j)  (256  + 64 * (j))
#define XB_XSUB(j)  (1280 + 64 * (j))
#define XB_XGEN(j)  (2304 + 64 * (j))
#define XB_TOP      3328
#define XB_TOPGEN   3392
#define XCD_BAR_WORDS 3456
#define XB_SPIN_CAP (1u << 18)

__device__ __forceinline__ unsigned xb_ld(unsigned* p)              { return __hip_atomic_load(p, __ATOMIC_RELAXED, __HIP_MEMORY_SCOPE_AGENT); }
__device__ __forceinline__ unsigned xb_add(unsigned* p, unsigned v) { return __hip_atomic_fetch_add(p, v, __ATOMIC_RELAXED, __HIP_MEMORY_SCOPE_AGENT); }
__device__ __forceinline__ unsigned xb_xcc_id() { return (unsigned)__builtin_amdgcn_s_getreg((3 << 11) | 20) & 0xFu; }
#define XB_SPIN(cond, bar) do { unsigned _sp = 0; while (cond) { __builtin_amdgcn_s_sleep(1); \
    if ((++_sp & 255u) == 0u) { if (xb_ld(&(bar)[XB_TMO])) break; if (_sp > XB_SPIN_CAP) { atomicAdd(&(bar)[XB_TMO], 1u); break; } } } } while (0)

struct XcdBarrier {
    unsigned* bar; unsigned x;
    volatile LAS unsigned* st;
};

__device__ __forceinline__ XcdBarrier xcd_barrier_post(unsigned* bar, volatile LAS unsigned* st) {
    XcdBarrier b; b.bar = bar; b.x = xb_xcc_id(); b.st = st;
    if (threadIdx.x == 0) (void)xb_add(&bar[XB_XCNT(b.x)], 1u);
    return b;
}
__device__ __forceinline__ void xcd_barrier_complete(unsigned* bar, unsigned x, unsigned& nloc, unsigned& nx) {
    const unsigned G = gridDim.x * gridDim.y * gridDim.z;
    unsigned sum, cnt, mine, sp = 0u;
    for (;;) {
        sum = 0u; cnt = 0u; mine = 0u;
#pragma unroll
        for (unsigned j = 0; j < 16; ++j) { const unsigned c = xb_ld(&bar[XB_XCNT(j)]); sum += c; cnt += (c > 0u) ? 1u : 0u; mine = (j == x) ? c : mine; }
        if (sum == G) break;
        __builtin_amdgcn_s_sleep(1);
        if ((++sp & 255u) == 0u) { if (xb_ld(&bar[XB_TMO])) break; if (sp > XB_SPIN_CAP) { atomicAdd(&bar[XB_TMO], 1u); break; } }
    }
    nloc = mine > 0u ? mine : 1u; nx = cnt > 0u ? cnt : 1u;
}

__device__ __forceinline__ void xcd_barrier(const XcdBarrier& b) {
    asm volatile("s_waitcnt vmcnt(0)" ::: "memory");
    __syncthreads();
    if (threadIdx.x == 0) {
        unsigned* bar = b.bar;
        __builtin_amdgcn_s_waitcnt(0);
        unsigned nloc = b.st[0], nx = b.st[1];
        if (nloc == 0u) { xcd_barrier_complete(bar, b.x, nloc, nx); b.st[0] = nloc; b.st[1] = nx; }
        const unsigned old = xb_add(&bar[XB_XSUB(b.x)], 1u);
        const unsigned gen = old / nloc;
        if (old + 1u == (gen + 1u) * nloc) {
            __builtin_amdgcn_fence(__ATOMIC_RELEASE, "agent");
            asm volatile("s_waitcnt vmcnt(0)" ::: "memory");
            const unsigned og = xb_add(&bar[XB_TOP], 1u);
            const unsigned tg = og / nx;
            if (og + 1u == (tg + 1u) * nx) xb_add(&bar[XB_TOPGEN], 1u);
            else XB_SPIN(xb_ld(&bar[XB_TOPGEN]) == tg, bar);
            __builtin_amdgcn_fence(__ATOMIC_ACQUIRE, "agent");
            xb_add(&bar[XB_XGEN(b.x)], 1u);
            asm volatile("s_waitcnt vmcnt(0)" ::: "memory");
        } else {
            XB_SPIN(xb_ld(&bar[XB_XGEN(b.x)]) == gen, bar);
            __builtin_amdgcn_fence(__ATOMIC_ACQUIRE, "agent");
            asm volatile("s_waitcnt vmcnt(0)" ::: "memory");
        }
    }
    __syncthreads();
}

constexpr int CW_BAR = 4096, MISC_OFF = RING_BYTES + 320;
constexpr size_t CTL_ZERO_BYTES = 64 * 1024;
static_assert((CW_BAR + XCD_BAR_WORDS) * 4 <= (int)CTL_ZERO_BYTES, "ctl");

struct Args { const float* in[23]; float* out; unsigned char* ws; int ph_lo, ph_hi; };
enum { I_XP = 0, I_XS, I_CCONV, I_CPOOL, I_CP, I_CS, I_ADAW, I_ADAB, I_LNG, I_LNB, I_FWIN, I_FWDN, I_MWIN, I_MBIN, I_CONVW, I_CONVB, I_CLNG, I_CLNB, I_POOLW, I_POOLB, I_PSCALE, I_MWOUT, I_MBOUT };

__device__ __forceinline__ void transpose_item(const float* W, int ldw, bf16* WT, int ldt, int k0, int n0, int drow0, LAS float* scr, int lane) {
#pragma unroll 8
    for (int i = 0; i < 32; ++i) { const int kk = 2 * i + (lane >> 5); scr[kk * 33 + (lane & 31)] = W[(size_t)(k0 + kk) * ldw + n0 + (lane & 31)]; }
    LDS_WAIT(); asm volatile("" ::: "memory");
    const int c = lane & 7;
#pragma unroll
    for (int j = 0; j < 4; ++j) { const int n = (lane >> 3) + 8 * j; const LAS float* s = scr + (8 * c) * 33 + n;
        v4u o; o.x = pk2(s[0 * 33], s[1 * 33]); o.y = pk2(s[2 * 33], s[3 * 33]); o.z = pk2(s[4 * 33], s[5 * 33]); o.w = pk2(s[6 * 33], s[7 * 33]);
        *(v4u*)(WT + (size_t)(drow0 + n) * ldt + k0 + 8 * c) = o; }
    LDS_WAIT(); asm volatile("" ::: "memory");
}
constexpr int I_IN = (D / 64) * (2 * DFF / 32), I_DN = (DFF / 64) * (D / 32), I_MI = (D / 64) * (INC / 32), I_MO = (CC / 64) * (D / 32), I_FOLD = 64 * 16, I_B = 16;
constexpr int N_WAVE_ITEMS = 2 * I_IN + 2 * I_DN + I_MI + I_MO + I_FOLD + I_B;
static_assert(N_WAVE_ITEMS % NWAVES == 0, "wave items per block item");
constexpr int N_MOD_ITEMS = NMOD / 64, N_BLOCK_ITEMS = N_MOD_ITEMS + N_WAVE_ITEMS / NWAVES;

__device__ __forceinline__ void p0_wave_item(const Args& a, int r, LAS float* scr, int lane) {
    unsigned char* ws = a.ws;
    for (int l = 0; l < 2; ++l) { if (r < I_IN) { const int nblk = 2 * DFF / 32, kb = r / nblk, nb = r % nblk, n0 = 32 * nb, h = n0 >= DFF ? 1 : 0, j = n0 - h * DFF;
            transpose_item(a.in[I_FWIN] + (size_t)l * D * 2 * DFF, 2 * DFF, (bf16*)(ws + (l ? WS_WIN2 : WS_WIN1)), D, 64 * kb, n0, 256 * (j >> 7) + 128 * h + (j & 127), scr, lane); return; } r -= I_IN; }
    for (int l = 0; l < 2; ++l) { if (r < I_DN) { const int nblk = D / 32, kb = r / nblk, nb = r % nblk;
            transpose_item(a.in[I_FWDN] + (size_t)l * DFF * D, D, (bf16*)(ws + (l ? WS_WDN2 : WS_WDN1)), DFF, 64 * kb, 32 * nb, 32 * nb, scr, lane); return; } r -= I_DN; }
    if (r < I_MI) { const int nblk = INC / 32, kb = r / nblk, nb = r % nblk, n0 = 32 * nb; int drow = n0;
        if (n0 < 1024) { const int h = n0 >= 512 ? 1 : 0, j = n0 - 512 * h; drow = 256 * (j >> 7) + 128 * h + (j & 127); }
        transpose_item(a.in[I_MWIN], INC, (bf16*)(ws + WS_WMI), D, 64 * kb, n0, drow, scr, lane); return; } r -= I_MI;
    if (r < I_MO) { const int nblk = D / 32, kb = r / nblk, nb = r % nblk;
        transpose_item(a.in[I_MWOUT], D, (bf16*)(ws + WS_WMO), D, 64 * kb, 32 * nb, 32 * nb, scr, lane); return; } r -= I_MO;
    const float* wout = a.in[I_MWOUT]; const float* pscale = a.in[I_PSCALE];
    if (r < I_FOLD) {
        const int cg8 = r >> 4, nb = r & 15, g = cg8 >> 4, cg0 = cg8 * 8, n = nb * 64 + lane;
        const float* pw = a.in[I_POOLW] + (size_t)cg0 * 128;
        float acc[8];
#pragma unroll
        for (int e = 0; e < 8; ++e) acc[e] = 0.f;
        for (int d = 0; d < 128; ++d) { const float w = wout[(size_t)(512 + g * 128 + d) * D + n] * pscale[g * 128 + d];
#pragma unroll
            for (int e = 0; e < 8; ++e) acc[e] += pw[e * 128 + d] * w; }
        v4u o; o.x = pk2(acc[0], acc[1]); o.y = pk2(acc[2], acc[3]); o.z = pk2(acc[4], acc[5]); o.w = pk2(acc[6], acc[7]);
        *(v4u*)((bf16*)(ws + WS_WMO) + (size_t)n * D + 512 + cg0) = o; return; } r -= I_FOLD;
    {
        const int n = r * 64 + lane; const float* pb = a.in[I_POOLB]; float acc = a.in[I_MBOUT][n];
        for (int j = 0; j < PC; ++j) acc += pb[j] * pscale[j] * wout[(size_t)(512 + j) * D + n];
        ((float*)(ws + WS_BIAS2))[n] = acc; }
}
__device__ __forceinline__ void p0_mod_item(const Args& a, int item, LAS unsigned char* lds, int tid, int wave, int lane) {
    LAS float* sc = (LAS float*)lds; LAS float* red = (LAS float*)(lds + NBATCH * D * 4);
    for (int idx = tid; idx < NBATCH * D; idx += NTHREADS) { const int b = idx >> 10, k = idx & 1023; const float c = b < NB_P ? a.in[I_CP][b * D + k] : a.in[I_CS][(b - NB_P) * D + k]; sc[idx] = c / (1.0f + __expf(-c)); }
    __syncthreads();
    const int j = item * 64 + lane; const float* aw = a.in[I_ADAW] + j;
    float acc[NBATCH];
#pragma unroll
    for (int b = 0; b < NBATCH; ++b) acc[b] = 0.f;
    for (int k4 = 0; k4 < 32; ++k4) { const int kk = wave * 128 + 4 * k4;
        const float a0 = aw[(size_t)(kk + 0) * NMOD], a1 = aw[(size_t)(kk + 1) * NMOD], a2 = aw[(size_t)(kk + 2) * NMOD], a3 = aw[(size_t)(kk + 3) * NMOD];
#pragma unroll
        for (int b = 0; b < NBATCH; ++b) { const f32x4 s = *(const LAS f32x4*)(sc + b * D + kk); acc[b] += (a0 * s.x + a1 * s.y) + (a2 * s.z + a3 * s.w); } }
#pragma unroll
    for (int b = 0; b < NBATCH; ++b) red[(wave * NBATCH + b) * 64 + lane] = acc[b];
    __syncthreads();
    for (int idx = tid; idx < NBATCH * 64; idx += NTHREADS) { const int b = idx >> 6, l = idx & 63; float s = a.in[I_ADAB][item * 64 + l];
#pragma unroll
        for (int w = 0; w < NWAVES; ++w) s += red[(w * NBATCH + b) * 64 + l];
        ((float*)(a.ws + WS_MOD))[(size_t)b * NMOD + item * 64 + l] = s; }
    __syncthreads();
}

__device__ __forceinline__ void store_mod_row(const f32x4 (&v)[4], const float* MOD, int m, int kmod, bf16* U, int lane) {
    const float* mp = MOD + (size_t)batch_of_row(m) * NMOD + 3 * kmod * D; const f32x4* sh = (const f32x4*)mp + lane; const f32x4* sc = (const f32x4*)(mp + D) + lane;
    v2u* o = (v2u*)(U + (size_t)m * D) + lane;
#pragma unroll
    for (int j = 0; j < 4; ++j) { const f32x4 u = v[j] * (sc[64 * j] + 1.0f) + sh[64 * j]; v2u w; w.x = pk2(u.x, u.y); w.y = pk2(u.z, u.w); o[64 * j] = w; }
}
__device__ __forceinline__ void modulate_phase(const Args& a, int G, int wave, int lane) {
    const float* MOD = (const float*)(a.ws + WS_MOD); bf16* U = (bf16*)(a.ws + WS_U);
    for (int m = blockIdx.x * NWAVES + wave; m < M; m += G * NWAVES) {
        const f32x4* xr = (const f32x4*)(m < M_P ? a.in[I_XP] + (size_t)m * D : a.in[I_XS] + (size_t)(m - M_P) * D) + lane;
        f32x4 v[4];
#pragma unroll
        for (int j = 0; j < 4; ++j) v[j] = xr[64 * j];
        store_mod_row(v, MOD, m, 0, U, lane);
    }
}
__device__ __forceinline__ void ln_phase(const Args& a, int kln, int kmod, int G, int wave, int lane) {
    const float* MOD = (const float*)(a.ws + WS_MOD); bf16* U = (bf16*)(a.ws + WS_U); float* XY = a.out + OUT_Y;
    f32x4 gv[4], bv[4];
#pragma unroll
    for (int j = 0; j < 4; ++j) { gv[j] = ((const f32x4*)(a.in[I_LNG] + kln * D))[lane + 64 * j]; bv[j] = ((const f32x4*)(a.in[I_LNB] + kln * D))[lane + 64 * j]; }
    for (int m = blockIdx.x * NWAVES + wave; m < M; m += G * NWAVES) {
        f32x4* xr = (f32x4*)(XY + (size_t)m * D) + lane;
        f32x4 v[4]; float s = 0.f;
#pragma unroll
        for (int j = 0; j < 4; ++j) { v[j] = xr[64 * j]; s += (v[j].x + v[j].y) + (v[j].z + v[j].w); }
        const float mean = wave_sum(s) * (1.f / D); float s2 = 0.f;
#pragma unroll
        for (int j = 0; j < 4; ++j) { v[j] = v[j] - mean; s2 += (v[j].x * v[j].x + v[j].y * v[j].y) + (v[j].z * v[j].z + v[j].w * v[j].w); }
        const float rstd = 1.f / sqrtf(wave_sum(s2) * (1.f / D) + LN_EPS);
#pragma unroll
        for (int j = 0; j < 4; ++j) { v[j] = v[j] * rstd * gv[j] + bv[j]; xr[64 * j] = v[j]; }
        if (kmod >= 0) store_mod_row(v, MOD, m, kmod, U, lane);
    }
}

constexpr int CT = 32;
__device__ __forceinline__ void convpool_unit(const Args& a, int unit, LAS unsigned char* lds, int tid, int wave, int lane) {
    const float* GLU = (const float*)(a.ws + WS_GLU); const float* ZP = (const float*)(a.ws + WS_ZP); bf16* A2 = (bf16*)(a.ws + WS_U);
    LAS float* tile = (LAS float*)lds;
    const int row0 = unit * CT; const bool samp = row0 >= M_P;
    int b, t0, Tlen, rowbase;
    if (!samp) { b = row0 >> 14; t0 = row0 & (T_P - 1); Tlen = T_P; rowbase = b * T_P; }
    else { const int r = row0 - M_P; b = r >> 6; t0 = r & (T_S - 1); Tlen = T_S; rowbase = M_P + b * T_S; }
    const bool last = (t0 + CT == Tlen);
    const int c = tid;
    {
        float w[CW], acc[CT];
#pragma unroll
        for (int k = 0; k < CW; ++k) w[k] = a.in[I_CONVW][k * CC + c];
        const float cb = a.in[I_CONVB][c];
#pragma unroll
        for (int tt = 0; tt < CT; ++tt) acc[tt] = cb;
        float* st = a.out + (samp ? OUT_SCS : OUT_SCP) + (size_t)b * CH * CC + c;
#pragma unroll
        for (int i = 0; i < CT + CH; ++i) { const int ti = t0 - CH + i; float val = 0.f;
            if (ti >= 0) val = GLU[(size_t)(rowbase + ti) * CC + c]; else if (samp) val = a.in[I_CCONV][(size_t)(b * CH + CH + ti) * CC + c];
            if (i >= CT && last) st[(size_t)(i - CT) * CC] = val;
#pragma unroll
            for (int tt = 0; tt < CT; ++tt) { const int k = i - tt; if (k >= 0 && k < CW) acc[tt] += w[k] * val; } }
#pragma unroll
        for (int tt = 0; tt < CT; ++tt) tile[tt * CC + c] = acc[tt];
    }
    {
        const int g = c >> 7, wnd = 2 << g;
        float in[CT + PH];
        float* st = a.out + (samp ? OUT_SPS : OUT_SPP) + (size_t)b * PH * PC + c;
#pragma unroll
        for (int i = 0; i < CT + PH; ++i) { const int ti = t0 - PH + i; float val = 0.f;
            if (ti >= 0) val = ZP[(size_t)(rowbase + ti) * PC + c]; else if (samp) val = a.in[I_CPOOL][(size_t)(b * PH + PH + ti) * PC + c];
            if (i >= CT && last) st[(size_t)(i - CT) * PC] = val;
            in[i] = val; }
        float s2[CT + PH], s4[CT + PH], s8[CT + PH], s16[CT + PH];
#pragma unroll
        for (int i = 0; i < CT + PH; ++i) { s2[i] = in[i] + (i >= 1 ? in[i - 1] : 0.f); }
#pragma unroll
        for (int i = 0; i < CT + PH; ++i) { s4[i] = s2[i] + (i >= 2 ? s2[i - 2] : 0.f); }
#pragma unroll
        for (int i = 0; i < CT + PH; ++i) { s8[i] = s4[i] + (i >= 4 ? s4[i - 4] : 0.f); }
#pragma unroll
        for (int i = 0; i < CT + PH; ++i) { s16[i] = s8[i] + (i >= 8 ? s8[i - 8] : 0.f); }
        bf16* op = A2 + (size_t)row0 * D + 512 + c;
#pragma unroll
        for (int tt = 0; tt < CT; ++tt) { const int i = PH + tt; const float wsum = g == 0 ? s2[i] : g == 1 ? s4[i] : g == 2 ? s8[i] : s16[i];
            const int pos = (samp ? PAST : 0) + t0 + tt; const int cnt = pos + 1 < wnd ? pos + 1 : wnd;
            const float pooled = wsum / (float)cnt - in[i];
            op[(size_t)tt * D] = (bf16)(pk2(pooled, 0.f) & 0xffffu); }
    }
    __syncthreads();
    {
        const f32x4 g0 = ((const f32x4*)a.in[I_CLNG])[lane], g1 = ((const f32x4*)a.in[I_CLNG])[64 + lane], b0 = ((const f32x4*)a.in[I_CLNB])[lane], b1 = ((const f32x4*)a.in[I_CLNB])[64 + lane];
#pragma unroll
        for (int q = 0; q < CT / NWAVES; ++q) { const int tt = wave * (CT / NWAVES) + q;
            f32x4 v0 = *(const LAS f32x4*)(tile + tt * CC + 4 * lane), v1 = *(const LAS f32x4*)(tile + tt * CC + 256 + 4 * lane);
            const float mean = wave_sum((v0.x + v0.y) + (v0.z + v0.w) + (v1.x + v1.y) + (v1.z + v1.w)) * (1.f / CC);
            v0 = v0 - mean; v1 = v1 - mean;
            const float var = wave_sum((v0.x * v0.x + v0.y * v0.y) + (v0.z * v0.z + v0.w * v0.w) + (v1.x * v1.x + v1.y * v1.y) + (v1.z * v1.z + v1.w * v1.w)) * (1.f / CC);
            const float rstd = 1.f / sqrtf(var + LN_EPS);
            v0 = v0 * rstd * g0 + b0; v1 = v1 * rstd * g1 + b1;
            v2u w0, w1; w0.x = pk2(pg8::silu_f(v0.x), pg8::silu_f(v0.y)); w0.y = pk2(pg8::silu_f(v0.z), pg8::silu_f(v0.w));
            w1.x = pk2(pg8::silu_f(v1.x), pg8::silu_f(v1.y)); w1.y = pk2(pg8::silu_f(v1.z), pg8::silu_f(v1.w));
            bf16* op = A2 + (size_t)(row0 + tt) * D;
            *(v2u*)(op + 4 * lane) = w0; *(v2u*)(op + 256 + 4 * lane) = w1; }
    }
    __syncthreads();
}

__global__ void __launch_bounds__(NTHREADS, 2) mk_fwd(Args a) {
    extern __shared__ __attribute__((aligned(16))) unsigned char lds_raw[];
    LAS unsigned char* lds = (LAS unsigned char*)lds_raw;
    const int tid = threadIdx.x, lane = tid & 63, wave = __builtin_amdgcn_readfirstlane(tid >> 6), G = gridDim.x;
    const int lo = a.ph_lo, hi = a.ph_hi;
    unsigned char* ws = a.ws;
    const float* MOD = (const float*)(ws + WS_MOD);
    bf16* U = (bf16*)(ws + WS_U); bf16* ACT = (bf16*)(ws + WS_ACT);
    float* XY = a.out + OUT_Y;
#define IN(k) (lo <= (k) && (k) < hi)
#define SEAM(k) do { if (IN(k) && IN((k) + 1)) xcd_barrier(bar); } while (0)

    for (int u = tid; u < (LDS_BYTES - RING_BYTES) / 4; u += NTHREADS) ((LAS unsigned*)(lds + RING_BYTES))[u] = 0u;
    __syncthreads();
    if (lo < 0) cg::this_grid().sync();
    XcdBarrier bar; bar.bar = (unsigned*)(ws + WS_CTL) + CW_BAR; bar.x = 0; bar.st = nullptr;
    if (hi - lo > 1) bar = xcd_barrier_post((unsigned*)(ws + WS_CTL) + CW_BAR, (volatile LAS unsigned*)(lds + MISC_OFF + 32));
    if (IN(0)) {
        for (int bi = blockIdx.x; bi < N_BLOCK_ITEMS; bi += G) {
            if (bi < N_MOD_ITEMS) p0_mod_item(a, bi, lds, tid, wave, lane);
            else p0_wave_item(a, (bi - N_MOD_ITEMS) * NWAVES + wave, (LAS float*)(lds + wave * 16384), lane);
        }
    }
    SEAM(0);
    if (IN(1)) modulate_phase(a, G, wave, lane);
    SEAM(1);
    if (IN(2)) { pg8::Gemm g{U, (const bf16*)(ws + WS_WIN1), M, 2 * DFF, D}; pg8::StaticOrder S; S.init(M, 2 * DFF, G, (int)blockIdx.x);
        pg8::EpiSwiGLU E{ACT, DFF}; pg8::gemm_phase<pg8::EpiSwiGLU, pg8::StaticOrder, true, true>(lds, g, S, E); }
    SEAM(2);
    if (IN(3)) { pg8::Gemm g{ACT, (const bf16*)(ws + WS_WDN1), M, D, DFF}; pg8::StaticOrder S; S.init(M, D, G, (int)blockIdx.x);
        pg8::EpiResid E{a.in[I_XP], a.in[I_XS], XY, MOD + 2 * D, nullptr, 0.5f}; pg8::gemm_phase<pg8::EpiResid, pg8::StaticOrder, true, true>(lds, g, S, E); }
    SEAM(3);
    if (IN(4)) ln_phase(a, 0, 1, G, wave, lane);
    SEAM(4);
    if (IN(5)) { pg8::Gemm g{U, (const bf16*)(ws + WS_WMI), M, INC, D}; pg8::StaticOrder S; S.init(M, INC, G, (int)blockIdx.x);
        pg8::EpiMixIn E{(float*)(ws + WS_GLU), (float*)(ws + WS_ZP), a.in[I_MBIN]}; pg8::gemm_phase<pg8::EpiMixIn, pg8::StaticOrder, true, true>(lds, g, S, E); }
    SEAM(5);
    if (IN(6)) { for (int u = blockIdx.x; u < M / CT; u += G) convpool_unit(a, u, lds, tid, wave, lane); }
    SEAM(6);
    if (IN(7)) { pg8::Gemm g{U, (const bf16*)(ws + WS_WMO), M, D, D}; pg8::StaticOrder S; S.init(M, D, G, (int)blockIdx.x);
        pg8::EpiResid E{XY, XY + (size_t)M_P * D, XY, MOD + 5 * D, (const float*)(ws + WS_BIAS2), 1.0f}; pg8::gemm_phase<pg8::EpiResid, pg8::StaticOrder, true, true>(lds, g, S, E); }
    SEAM(7);
    if (IN(8)) ln_phase(a, 1, 2, G, wave, lane);
    SEAM(8);
    if (IN(9)) { pg8::Gemm g{U, (const bf16*)(ws + WS_WIN2), M, 2 * DFF, D}; pg8::StaticOrder S; S.init(M, 2 * DFF, G, (int)blockIdx.x);
        pg8::EpiSwiGLU E{ACT, DFF}; pg8::gemm_phase<pg8::EpiSwiGLU, pg8::StaticOrder, true, true>(lds, g, S, E); }
    SEAM(9);
    if (IN(10)) { pg8::Gemm g{ACT, (const bf16*)(ws + WS_WDN2), M, D, DFF}; pg8::StaticOrder S; S.init(M, D, G, (int)blockIdx.x);
        pg8::EpiResid E{XY, XY + (size_t)M_P * D, XY, MOD + 8 * D, nullptr, 0.5f}; pg8::gemm_phase<pg8::EpiResid, pg8::StaticOrder, true, true>(lds, g, S, E); }
    SEAM(10);
    if (IN(11)) ln_phase(a, 2, -1, G, wave, lane);
#undef IN
#undef SEAM
}

extern "C" void kernel_launch(void* const* d_in, const int* in_sizes, int n_in, void* d_out, int out_size, void* d_ws, size_t ws_size, hipStream_t stream) {
    static int grid = 0;
    if (grid == 0) {
        if (n_in != 23 || in_sizes[0] != M_P * D || in_sizes[1] != M_S * D || (size_t)out_size != OUT_END || ws_size < WS_END) {
            fprintf(stderr, "kernel_launch: unexpected shapes (n_in %d, in0 %d, out %d, ws %zu); nothing launched\n", n_in, n_in > 0 ? in_sizes[0] : -1, out_size, ws_size); grid = -1; return; }
        int dev = 0, cus = 0, per_cu = 0;
        if (hipGetDevice(&dev) != hipSuccess || hipDeviceGetAttribute(&cus, hipDeviceAttributeMultiprocessorCount, dev) != hipSuccess) { fprintf(stderr, "kernel_launch: device query failed\n"); grid = -1; return; }
        if (hipFuncSetAttribute((const void*)mk_fwd, hipFuncAttributeMaxDynamicSharedMemorySize, LDS_BYTES) != hipSuccess) { fprintf(stderr, "kernel_launch: hipFuncSetAttribute failed\n"); grid = -1; return; }
        if (hipOccupancyMaxActiveBlocksPerMultiprocessor(&per_cu, (const void*)mk_fwd, NTHREADS, LDS_BYTES) != hipSuccess || per_cu < 1) { per_cu = 1; (void)hipGetLastError(); }
        grid = cus * per_cu;
    }
    if (grid < 0) return;
    if (hipMemsetAsync((char*)d_ws + WS_CTL, 0, CTL_ZERO_BYTES, stream) != hipSuccess) { fprintf(stderr, "kernel_launch: memset failed\n"); return; }
    Args a{};
    for (int i = 0; i < 23; ++i) a.in[i] = (const float*)d_in[i];
    a.out = (float*)d_out; a.ws = (unsigned char*)d_ws;
    if (N_LAUNCHES == 1) {
        a.ph_lo = 0; a.ph_hi = NPHASE;
        void* kargs[] = {&a};
        const hipError_t e = hipLaunchCooperativeKernel((const void*)mk_fwd, dim3(grid), dim3(NTHREADS), kargs, LDS_BYTES, stream);
        if (e != hipSuccess) fprintf(stderr, "kernel_launch: cooperative launch failed: %s (grid %d)\n", hipGetErrorString(e), grid);
    } else {
        for (int p = 0; p < NPHASE; ++p) { a.ph_lo = p; a.ph_hi = p + 1; hipLaunchKernelGGL(mk_fwd, dim3(grid), dim3(NTHREADS), LDS_BYTES, stream, a); }
    }
}
```

```cpp
#include <hip/hip_runtime.h>
#include <hip/hip_cooperative_groups.h>
#include <cstdio>
#include <cstdint>
namespace cg = cooperative_groups;

constexpr int D = 1024, DFF = 2816, T_P = 16384, NB_P = 2, T_S = 64, NB_S = 16;
constexpr int M_P = NB_P * T_P, M_S = NB_S * T_S, M = M_P + M_S;
constexpr int NBATCH = NB_P + NB_S, NMOD = 9 * D;
constexpr int CC = 512, PC = 512, INC = 1536, CW = 31, CH = 30, PH = 15, PAST = 4096;
constexpr float LN_EPS = 1e-5f;
constexpr float ALPHA = 1.189207115002721f;
constexpr size_t OUT_Y = 0, OUT_SCP = (size_t)M * D, OUT_SPP = OUT_SCP + (size_t)NB_P * CH * CC, OUT_SCS = OUT_SPP + (size_t)NB_P * PH * PC,
                 OUT_SPS = OUT_SCS + (size_t)NB_S * CH * CC, OUT_END = OUT_SPS + (size_t)NB_S * PH * PC;
constexpr size_t MiB = 1u << 20;
constexpr size_t WS_CTL = 0, WS_MOD = 1 * MiB, WS_BIAS2 = 1 * MiB + 768 * 1024;
constexpr size_t WS_WIN1 = 2 * MiB, WS_WIN2 = 13 * MiB, WS_WDN1 = 24 * MiB, WS_WDN2 = 30 * MiB, WS_WMI = 36 * MiB, WS_WMO = 39 * MiB;
constexpr size_t WS_U = 48 * MiB;
constexpr size_t WS_ACT = 114 * MiB;
constexpr size_t WS_GLU = WS_ACT, WS_ZP = WS_ACT + 66 * MiB;
constexpr size_t WS_END = 296 * MiB;
static_assert((size_t)NBATCH * NMOD * 4 <= 768 * 1024, "mod");
static_assert(WS_U + (size_t)M * D * 2 <= WS_ACT && WS_ACT + (size_t)M * DFF * 2 <= WS_END && WS_ZP + (size_t)M * PC * 4 <= WS_END, "ws map");
static_assert((size_t)M * CC * 4 == 66 * MiB, "glu size");

__device__ __forceinline__ int batch_of_row(int r) { return r < M_P ? (r >> 14) : NB_P + ((r - M_P) >> 6); }

namespace pg8 {
#define PG8_LAS __attribute__((address_space(3)))
typedef unsigned short bf16_t;
typedef short bf16x8 __attribute__((ext_vector_type(8)));
typedef float f32x4 __attribute__((ext_vector_type(4)));
typedef unsigned u32x4 __attribute__((ext_vector_type(4)));
constexpr int BM = 256, BK = 64, HALF = 128, HTB = HALF * BK * 2  , STAGE_BYTES = 8 * HTB, NXCD = 8, WGM = 8;

__host__ __device__ __forceinline__ int lds_byte(int r, int c) { const int st = (r >> 4) * 2 + (c >> 5), rr = r & 15, cc = c & 31, ob = rr * 64 + cc * 2; return st * 1024 + (ob ^ (((ob >> 9) & 1) << 5)); }
__host__ __device__ __forceinline__ void stage_rc(int b, int& R, int& C) { const int st = b / 1024, sb = b % 1024, swz = sb ^ (((sb >> 9) & 1) << 5); R = (st >> 1) * 16 + swz / 64; C = (st & 1) * 32 + (swz % 64) / 2; }
__host__ __device__ __forceinline__ int perm32(int rho) { const int n = rho >> 4, i = rho & 15; return 8 * (i >> 2) + 4 * n + (i & 3); }

struct Unit { int pm, pn; };
struct Gemm { const bf16_t* A; const bf16_t* Bt; int M, N, K; };

struct StaticOrder {
    int nM, nN, nwg, G, c;
    __host__ __device__ void init(int M, int N, int G_, int c_) { nM = M / BM; nN = N / BM; nwg = nM * nN; G = G_; c = c_; }
    __host__ __device__ bool next(int i, Unit& u) const {
        const long L = (long)i * G + c; if (L >= nwg) return false;
        int wgid = (int)L; { const int q = nwg / NXCD, r = nwg % NXCD, xcd = wgid % NXCD, off = wgid / NXCD; wgid = (xcd < r ? xcd * (q + 1) : r * (q + 1) + (xcd - r) * q) + off; }
        const int nig = WGM * nN, gid = wgid / nig, fm = gid * WGM, gsz = (nM - fm) < WGM ? (nM - fm) : WGM;
        u.pm = fm + ((wgid % nig) % gsz); u.pn = (wgid % nig) / gsz; return true;
    }
    __device__ __forceinline__ void a_ready(const Unit&) const {}
    __device__ __forceinline__ void done(const Unit&) const {}
};


__device__ __forceinline__ unsigned cvt_pk_bf16(float lo, float hi) { unsigned r; asm volatile("v_cvt_pk_bf16_f32 %0, %1, %2" : "=v"(r) : "v"(lo), "v"(hi)); return r; }
__device__ __forceinline__ float sigmoid_f(float g) { return __builtin_amdgcn_rcpf(1.0f + __expf(-g)); }
__device__ __forceinline__ float silu_f(float g) { return g * sigmoid_f(g); }

struct EpiSwiGLU {
    static constexpr bool PERM = true, AFTER_DRAIN = false;
    bf16_t* O; int ldc;
    __device__ __forceinline__ void operator()(const f32x4 (&acc)[2][2][4][2], const Unit& u, int wr, int wc, int fr, int fq) const {
        const int row0 = u.pm * BM + wr * 64 + fr, col0 = u.pn * HALF + wc * 32 + 8 * fq;
#pragma unroll
        for (int ai = 0; ai < 2; ++ai)
#pragma unroll
            for (int m = 0; m < 4; ++m) { bf16_t* rowp = O + (size_t)(row0 + ai * HALF + m * 16) * ldc + col0;
                const f32x4 g0 = acc[ai][0][m][0], g1 = acc[ai][0][m][1], v0 = acc[ai][1][m][0], v1 = acc[ai][1][m][1];
                f32x4 h0, h1;
#pragma unroll
                for (int e = 0; e < 4; ++e) { h0[e] = silu_f(g0[e]) * v0[e]; h1[e] = silu_f(g1[e]) * v1[e]; }
                u32x4 w; w.x = cvt_pk_bf16(h0[0], h0[1]); w.y = cvt_pk_bf16(h0[2], h0[3]); w.z = cvt_pk_bf16(h1[0], h1[1]); w.w = cvt_pk_bf16(h1[2], h1[3]);
                *(u32x4*)rowp = w; }
    }
};

struct EpiMixIn {
    static constexpr bool PERM = false, AFTER_DRAIN = false;
    float* GLU; float* ZP; const float* bias;
    __device__ __forceinline__ void operator()(const f32x4 (&acc)[2][2][4][2], const Unit& u, int wr, int wc, int fr, int fq) const {
        const int row0 = u.pm * BM + wr * 64 + fr;
        if (u.pn < 4) {
            const int cb = u.pn * HALF + wc * 32 + 4 * fq;
            f32x4 ba[2], bb[2];
#pragma unroll
            for (int n = 0; n < 2; ++n) { ba[n] = *(const f32x4*)(bias + cb + 16 * n); bb[n] = *(const f32x4*)(bias + 512 + cb + 16 * n); }
#pragma unroll
            for (int ai = 0; ai < 2; ++ai)
#pragma unroll
                for (int m = 0; m < 4; ++m) { float* rowp = GLU + (size_t)(row0 + ai * HALF + m * 16) * CC + cb;
#pragma unroll
                    for (int n = 0; n < 2; ++n) { const f32x4 za = acc[ai][0][m][n] + ba[n], zb = acc[ai][1][m][n] + bb[n]; f32x4 o;
#pragma unroll
                        for (int e = 0; e < 4; ++e) o[e] = za[e] * sigmoid_f(zb[e]);
                        *(f32x4*)(rowp + 16 * n) = o; } }
        } else {
            const int cb = (u.pn - 4) * BM + wc * 32 + 4 * fq;
            f32x4 bv[2][2];
#pragma unroll
            for (int bj = 0; bj < 2; ++bj)
#pragma unroll
                for (int n = 0; n < 2; ++n) bv[bj][n] = *(const f32x4*)(bias + 1024 + cb + bj * HALF + 16 * n);
#pragma unroll
            for (int ai = 0; ai < 2; ++ai)
#pragma unroll
                for (int m = 0; m < 4; ++m) { float* rowp = ZP + (size_t)(row0 + ai * HALF + m * 16) * PC + cb;
#pragma unroll
                    for (int bj = 0; bj < 2; ++bj)
#pragma unroll
                        for (int n = 0; n < 2; ++n) *(f32x4*)(rowp + bj * HALF + 16 * n) = acc[ai][bj][m][n] + bv[bj][n]; }
        }
    }
};

struct EpiResid {
    static constexpr bool PERM = false, AFTER_DRAIN = false;
    const float* res_p; const float* res_s; float* out; const float* gate; const float* bias; float gs;
    __device__ __forceinline__ void operator()(const f32x4 (&acc)[2][2][4][2], const Unit& u, int wr, int wc, int fr, int fq) const {
        const int c0 = u.pn * BM + wc * 32 + 4 * fq;
#pragma unroll
        for (int ai = 0; ai < 2; ++ai) {
            const int rbase = u.pm * BM + ai * HALF + wr * 64;
            const float* gp = gate + (size_t)batch_of_row(rbase) * NMOD + c0;
            f32x4 gv[2][2], bv[2][2];
#pragma unroll
            for (int bj = 0; bj < 2; ++bj)
#pragma unroll
                for (int n = 0; n < 2; ++n) { gv[bj][n] = *(const f32x4*)(gp + bj * HALF + 16 * n) * gs;
                    bv[bj][n] = bias ? *(const f32x4*)(bias + c0 + bj * HALF + 16 * n) : (f32x4){0.f, 0.f, 0.f, 0.f}; }
#pragma unroll
            for (int m = 0; m < 4; ++m) { const int r = rbase + m * 16 + fr;
                const float* rp = (r < M_P ? res_p + (size_t)r * D : res_s + (size_t)(r - M_P) * D) + c0; float* op = out + (size_t)r * D + c0;
#pragma unroll
                for (int bj = 0; bj < 2; ++bj)
#pragma unroll
                    for (int n = 0; n < 2; ++n) { const f32x4 x = *(const f32x4*)(rp + bj * HALF + 16 * n);
                        *(f32x4*)(op + bj * HALF + 16 * n) = x * ALPHA + gv[bj][n] * (acc[ai][bj][m][n] + bv[bj][n]); } }
        }
    }
};

template <class Epi, class Sched, bool ALIGN_EPI = false, bool SP2 = false>
__device__ __forceinline__ void gemm_phase(PG8_LAS unsigned char* lds, const Gemm g, const Sched& S, const Epi& E) {
    const int tid = threadIdx.x, wid = __builtin_amdgcn_readfirstlane(tid >> 6), lane = tid & 63, wr = wid >> 2, wc = wid & 3, fr = lane & 15, fq = lane >> 4;
    const int K = g.K, nt = K / BK;
    unsigned voffA[2], voffB[2];
#pragma unroll
    for (int i = 0; i < 2; ++i) { int R, C; stage_rc(tid * 16 + i * 8192, R, C); const int Rb = Epi::PERM ? ((R & ~31) + perm32(R & 31)) : R;
        voffA[i] = (unsigned)(R * K + C) * 2u; voffB[i] = (unsigned)(Rb * K + C) * 2u; }
    const size_t kstep = (size_t)(BK * 2);
    const size_t hstep = (size_t)HALF * K * 2;
    const size_t tstep = 2 * hstep;
    const unsigned ldsw = (unsigned)wid * 1024u;
    const int aoff = lds_byte(wr * 64 + fr, fq * 8), boff = lds_byte(wc * 32 + fr, fq * 8);
#define PG8_SA(b, h) (((b) * 2 + (h)) * HTB)
#define PG8_SB(b, h) ((4 + (b) * 2 + (h)) * HTB)
#define PG8_STAGE(bufoff, gbase, voff) do { _Pragma("unroll") for (int _i = 0; _i < 2; ++_i) \
        __builtin_amdgcn_global_load_lds((const unsigned*)((const char*)(gbase) + (voff)[_i]), (PG8_LAS unsigned*)(lds + (bufoff) + ldsw + _i * 8192), 16, 0, 0); } while (0)
#define PG8_LDA(dst, b, h) do { _Pragma("unroll") for (int m = 0; m < 4; ++m) _Pragma("unroll") for (int k = 0; k < 2; ++k) dst[m][k] = *(const PG8_LAS bf16x8*)(lds + PG8_SA(b, h) + aoff + m * 2048 + k * 1024); } while (0)
#define PG8_LDB(dst, b, h) do { _Pragma("unroll") for (int n = 0; n < 2; ++n) _Pragma("unroll") for (int k = 0; k < 2; ++k) dst[n][k] = *(const PG8_LAS bf16x8*)(lds + PG8_SB(b, h) + boff + n * 2048 + k * 1024); } while (0)
#define PG8_MMA(ai, bj, At, Bt) do { __builtin_amdgcn_s_setprio(1); _Pragma("unroll") for (int m = 0; m < 4; ++m) _Pragma("unroll") for (int n = 0; n < 2; ++n) _Pragma("unroll") for (int k = 0; k < 2; ++k) \
        acc[ai][bj][m][n] = __builtin_amdgcn_mfma_f32_16x16x32_bf16(Bt[n][k], At[m][k], acc[ai][bj][m][n], 0, 0, 0); __builtin_amdgcn_s_setprio(0); } while (0)
#define PG8_WAIT_V(n) asm volatile("s_waitcnt vmcnt(" #n ")" ::: "memory")
#define PG8_WAIT_L(n) asm volatile("s_waitcnt lgkmcnt(" #n ")" ::: "memory")
#define PG8_BAR __builtin_amdgcn_s_barrier()
#define PG8_SCHED __builtin_amdgcn_sched_barrier(0)
    Unit cur, nxt; int ui = 0;
    if (!S.next(0, cur)) return;
    f32x4 acc[2][2][4][2];
#pragma unroll
    for (int a = 0; a < 2; ++a)
#pragma unroll
        for (int b = 0; b < 2; ++b)
#pragma unroll
            for (int m = 0; m < 4; ++m)
#pragma unroll
                for (int n = 0; n < 2; ++n) acc[a][b][m][n] = (f32x4){0.f, 0.f, 0.f, 0.f};
    bf16x8 At[4][2], B0[2][2], B1[2][2];
    const char* cA = (const char*)g.A + (size_t)cur.pm * tstep; const char* cB = (const char*)g.Bt + (size_t)cur.pn * tstep;
    S.a_ready(cur);
    if constexpr (SP2) {
        PG8_STAGE(PG8_SB(0, 0), cB, voffB); PG8_STAGE(PG8_SB(0, 1), cB + hstep, voffB); PG8_STAGE(PG8_SA(0, 0), cA, voffA); PG8_STAGE(PG8_SA(0, 1), cA + hstep, voffA);
        if (wr == 1) PG8_BAR;
        PG8_WAIT_V(2); PG8_BAR;
        PG8_STAGE(PG8_SB(1, 0), cB + kstep, voffB); PG8_STAGE(PG8_SA(1, 0), cA + kstep, voffA); PG8_STAGE(PG8_SB(1, 1), cB + hstep + kstep, voffB);
        PG8_WAIT_V(6); PG8_BAR;
    } else {
        PG8_STAGE(PG8_SB(0, 0), cB, voffB); PG8_STAGE(PG8_SA(0, 0), cA, voffA); PG8_STAGE(PG8_SB(0, 1), cB + hstep, voffB); PG8_STAGE(PG8_SA(0, 1), cA + hstep, voffA);
        if (wr == 1) PG8_BAR;
        PG8_WAIT_V(4); PG8_BAR;
        PG8_STAGE(PG8_SB(1, 0), cB + kstep, voffB); PG8_STAGE(PG8_SA(1, 0), cA + kstep, voffA); PG8_STAGE(PG8_SB(1, 1), cB + hstep + kstep, voffB);
        PG8_WAIT_V(6); PG8_BAR;
    }
    for (;;) {
        const bool has_next = S.next(ui + 1, nxt);
        const char* nA = has_next ? (const char*)g.A + (size_t)nxt.pm * tstep : cA; const char* nB = has_next ? (const char*)g.Bt + (size_t)nxt.pn * tstep : cB;
        for (int t = 0; t < nt; t += 2) {
            const bool last = (t == nt - 2);
            const char* a1 = cA + (size_t)(t + 1) * kstep;
            const char* a2 = last ? nA : cA + (size_t)(t + 2) * kstep; const char* b2 = last ? nB : cB + (size_t)(t + 2) * kstep;
            const char* a3 = a2 + kstep; const char* b3 = b2 + kstep;
            if (last && has_next) S.a_ready(nxt);
            if constexpr (SP2) {
            PG8_LDB(B0, 0, 0); PG8_LDB(B1, 0, 1); PG8_SCHED; PG8_LDA(At, 0, 0); PG8_STAGE(PG8_SA(1, 1), a1 + hstep, voffA);
            PG8_WAIT_V(8); PG8_WAIT_L(0); PG8_BAR; PG8_MMA(0, 0, At, B0); PG8_MMA(0, 1, At, B1); PG8_BAR; PG8_SCHED;
            PG8_LDA(At, 0, 1); PG8_STAGE(PG8_SB(0, 0), b2, voffB); PG8_STAGE(PG8_SB(0, 1), b2 + hstep, voffB); PG8_STAGE(PG8_SA(0, 0), a2, voffA);
            PG8_WAIT_V(8); PG8_WAIT_L(0); PG8_BAR; PG8_MMA(1, 0, At, B0); PG8_MMA(1, 1, At, B1); PG8_BAR; PG8_SCHED;
            PG8_LDB(B0, 1, 0); PG8_LDB(B1, 1, 1); PG8_SCHED; PG8_LDA(At, 1, 0); PG8_STAGE(PG8_SA(0, 1), a2 + hstep, voffA);
            PG8_WAIT_V(8); PG8_WAIT_L(0); PG8_BAR; PG8_MMA(0, 0, At, B0); PG8_MMA(0, 1, At, B1); PG8_BAR; PG8_SCHED;
            PG8_LDA(At, 1, 1); PG8_STAGE(PG8_SB(1, 0), b3, voffB); PG8_STAGE(PG8_SB(1, 1), b3 + hstep, voffB); PG8_STAGE(PG8_SA(1, 0), a3, voffA);
            PG8_WAIT_V(8); PG8_WAIT_L(0); PG8_BAR; PG8_MMA(1, 0, At, B0); PG8_MMA(1, 1, At, B1); PG8_BAR; PG8_SCHED;
            } else {
            PG8_LDB(B0, 0, 0); PG8_SCHED; PG8_LDA(At, 0, 0); PG8_STAGE(PG8_SA(1, 1), a1 + hstep, voffA);
            PG8_WAIT_L(8); PG8_BAR; PG8_WAIT_L(0); PG8_MMA(0, 0, At, B0); PG8_BAR; PG8_SCHED;
            PG8_LDB(B1, 0, 1); PG8_STAGE(PG8_SB(0, 0), b2, voffB);
            PG8_BAR; PG8_WAIT_L(0); PG8_MMA(0, 1, At, B1); PG8_BAR;
            PG8_LDA(At, 0, 1); PG8_STAGE(PG8_SA(0, 0), a2, voffA);
            PG8_BAR; PG8_WAIT_L(0); PG8_MMA(1, 0, At, B0); PG8_BAR; PG8_SCHED;
            PG8_STAGE(PG8_SB(0, 1), b2 + hstep, voffB);
            PG8_WAIT_V(6); PG8_BAR; PG8_MMA(1, 1, At, B1); PG8_BAR;
            PG8_LDB(B0, 1, 0); PG8_SCHED; PG8_LDA(At, 1, 0); PG8_STAGE(PG8_SA(0, 1), a2 + hstep, voffA);
            PG8_WAIT_L(8); PG8_BAR; PG8_WAIT_L(0); PG8_MMA(0, 0, At, B0); PG8_BAR; PG8_SCHED;
            PG8_LDB(B1, 1, 1); PG8_STAGE(PG8_SB(1, 0), b3, voffB);
            PG8_BAR; PG8_WAIT_L(0); PG8_MMA(0, 1, At, B1); PG8_BAR;
            PG8_LDA(At, 1, 1); PG8_STAGE(PG8_SA(1, 0), a3, voffA);
            PG8_BAR; PG8_WAIT_L(0); PG8_MMA(1, 0, At, B0); PG8_BAR; PG8_SCHED;
            PG8_STAGE(PG8_SB(1, 1), b3 + hstep, voffB);
            PG8_WAIT_V(6); PG8_BAR; PG8_MMA(1, 1, At, B1); PG8_BAR;
            }
        }
        if constexpr (ALIGN_EPI) { if (wr == 0) PG8_BAR; }
        if constexpr (!Epi::AFTER_DRAIN) { E(acc, cur, wr, wc, fr, fq); S.done(cur); }
        if (!has_next) break;
#pragma unroll
        for (int a = 0; a < 2; ++a)
#pragma unroll
            for (int b = 0; b < 2; ++b)
#pragma unroll
                for (int m = 0; m < 4; ++m)
#pragma unroll
                    for (int n = 0; n < 2; ++n) acc[a][b][m][n] = (f32x4){0.f, 0.f, 0.f, 0.f};
        cur = nxt; cA = nA; cB = nB; ++ui;
        if constexpr (ALIGN_EPI) { if (wr == 1) PG8_BAR; }
    }
    PG8_WAIT_V(0);
    if constexpr (!ALIGN_EPI) { if (wr == 0) PG8_BAR; }
    PG8_BAR;
    if constexpr (Epi::AFTER_DRAIN) { E.fused(acc, cur, wr, wc, fr, fq, lds, wid, lane); S.done(cur); }
#undef PG8_SA
#undef PG8_SB
#undef PG8_STAGE
#undef PG8_LDA
#undef PG8_LDB
#undef PG8_MMA
#undef PG8_WAIT_V
#undef PG8_WAIT_L
#undef PG8_BAR
#undef PG8_SCHED
}
}

constexpr int NWAVES = 8, NTHREADS = NWAVES * 64;
constexpr int NPHASE = 12;
#ifndef MK_N_LAUNCHES
#define MK_N_LAUNCHES 1
#endif
constexpr int N_LAUNCHES = MK_N_LAUNCHES;
constexpr int RING_BYTES = 131072, LDS_BYTES = 147456;

#define GAS __attribute__((address_space(1)))
#define LAS __attribute__((address_space(3)))
typedef unsigned short bf16;
typedef unsigned v4u __attribute__((ext_vector_type(4)));
typedef unsigned v2u __attribute__((ext_vector_type(2)));
typedef float f32x4 __attribute__((ext_vector_type(4)));
#define LDS_WAIT() asm volatile("s_waitcnt lgkmcnt(0)" ::: "memory")
__device__ __forceinline__ unsigned pk2(float lo, float hi) { return pg8::cvt_pk_bf16(lo, hi); }
__device__ __forceinline__ float wave_sum(float v) {
#pragma unroll
    for (int o = 1; o < 64; o <<= 1) v += __shfl_xor(v, o);
    return v;
}

typedef GAS unsigned gu32;
#define RLX_AGENT __ATOMIC_RELAXED, __HIP_MEMORY_SCOPE_AGENT
#define VM_WAIT() asm volatile("s_waitcnt vmcnt(0)" ::: "memory")
__device__ __forceinline__ unsigned long long rt() { return __builtin_amdgcn_s_memrealtime(); }

#define XB_TMO      128
#define XB_XCNT(j)  (256  + 64 * (j))
#define XB_XSUB(j)  (1280 + 64 * (j))
#define XB_XGEN(j)  (2304 + 64 * (j))
#define XB_TOP      3328
#define XB_TOPGEN   3392
#define XCD_BAR_WORDS 3456
#define XB_SPIN_CAP (1u << 18)

__device__ __forceinline__ unsigned xb_ld(unsigned* p)              { return __hip_atomic_load(p, __ATOMIC_RELAXED, __HIP_MEMORY_SCOPE_AGENT); }
__device__ __forceinline__ unsigned xb_add(unsigned* p, unsigned v) { return __hip_atomic_fetch_add(p, v, __ATOMIC_RELAXED, __HIP_MEMORY_SCOPE_AGENT); }
__device__ __forceinline__ unsigned xb_xcc_id() { return (unsigned)__builtin_amdgcn_s_getreg((3 << 11) | 20) & 0xFu; }
#define XB_SPIN(cond, bar) do { unsigned _sp = 0; while (cond) { __builtin_amdgcn_s_sleep(1); \
    if ((++_sp & 255u) == 0u) { if (xb_ld(&(bar)[XB_TMO])) break; if (_sp > XB_SPIN_CAP) { atomicAdd(&(bar)[XB_TMO], 1u); break; } } } } while (0)

struct XcdBarrier {
    unsigned* bar; unsigned x;
    volatile LAS unsigned* st;
};

__device__ __forceinline__ XcdBarrier xcd_barrier_post(unsigned* bar, volatile LAS unsigned* st) {
    XcdBarrier b; b.bar = bar; b.x = xb_xcc_id(); b.st = st;
    if (threadIdx.x == 0) (void)xb_add(&bar[XB_XCNT(b.x)], 1u);
    return b;
}
__device__ __forceinline__ void xcd_barrier_complete(unsigned* bar, unsigned x, unsigned& nloc, unsigned& nx) {
    const unsigned G = gridDim.x * gridDim.y * gridDim.z;
    unsigned sum, cnt, mine, sp = 0u;
    for (;;) {
        sum = 0u; cnt = 0u; mine = 0u;
#pragma unroll
        for (unsigned j = 0; j < 16; ++j) { const unsigned c = xb_ld(&bar[XB_XCNT(j)]); sum += c; cnt += (c > 0u) ? 1u : 0u; mine = (j == x) ? c : mine; }
        if (sum == G) break;
        __builtin_amdgcn_s_sleep(1);
        if ((++sp & 255u) == 0u) { if (xb_ld(&bar[XB_TMO])) break; if (sp > XB_SPIN_CAP) { atomicAdd(&bar[XB_TMO], 1u); break; } }
    }
    nloc = mine > 0u ? mine : 1u; nx = cnt > 0u ? cnt : 1u;
}

__device__ __forceinline__ void xcd_barrier(const XcdBarrier& b) {
    asm volatile("s_waitcnt vmcnt(0)" ::: "memory");
    __syncthreads();
    if (threadIdx.x == 0) {
        unsigned* bar = b.bar;
        __builtin_amdgcn_s_waitcnt(0);
        unsigned nloc = b.st[0], nx = b.st[1];
        if (nloc == 0u) { xcd_barrier_complete(bar, b.x, nloc, nx); b.st[0] = nloc; b.st[1] = nx; }
        const unsigned old = xb_add(&bar[XB_XSUB(b.x)], 1u);
        const unsigned gen = old / nloc;
        if (old + 1u == (gen + 1u) * nloc) {
            __builtin_amdgcn_fence(__ATOMIC_RELEASE, "agent");
            asm volatile("s_waitcnt vmcnt(0)" ::: "memory");
            const unsigned og = xb_add(&bar[XB_TOP], 1u);
            const unsigned tg = og / nx;
            if (og + 1u == (tg + 1u) * nx) xb_add(&bar[XB_TOPGEN], 1u);
            else XB_SPIN(xb_ld(&bar[XB_TOPGEN]) == tg, bar);
            __builtin_amdgcn_fence(__ATOMIC_ACQUIRE, "agent");
            xb_add(&bar[XB_XGEN(b.x)], 1u);
            asm volatile("s_waitcnt vmcnt(0)" ::: "memory");
        } else {
            XB_SPIN(xb_ld(&bar[XB_XGEN(b.x)]) == gen, bar);
            __builtin_amdgcn_fence(__ATOMIC_ACQUIRE, "agent");
            asm volatile("s_waitcnt vmcnt(0)" ::: "memory");
        }
    }
    __syncthreads();
}

constexpr int CW_BAR = 4096, MISC_OFF = RING_BYTES + 320;
constexpr size_t CTL_ZERO_BYTES = 64 * 1024;
static_assert((CW_BAR + XCD_BAR_WORDS) * 4 <= (int)CTL_ZERO_BYTES, "ctl");

struct Args { const float* in[23]; float* out; unsigned char* ws; int ph_lo, ph_hi; };
enum { I_XP = 0, I_XS, I_CCONV, I_CPOOL, I_CP, I_CS, I_ADAW, I_ADAB, I_LNG, I_LNB, I_FWIN, I_FWDN, I_MWIN, I_MBIN, I_CONVW, I_CONVB, I_CLNG, I_CLNB, I_POOLW, I_POOLB, I_PSCALE, I_MWOUT, I_MBOUT };

__device__ __forceinline__ void transpose_item(const float* W, int ldw, bf16* WT, int ldt, int k0, int n0, int drow0, LAS float* scr, int lane) {
#pragma unroll 8
    for (int i = 0; i < 32; ++i) { const int kk = 2 * i + (lane >> 5); scr[kk * 33 + (lane & 31)] = W[(size_t)(k0 + kk) * ldw + n0 + (lane & 31)]; }
    LDS_WAIT(); asm volatile("" ::: "memory");
    const int c = lane & 7;
#pragma unroll
    for (int j = 0; j < 4; ++j) { const int n = (lane >> 3) + 8 * j; const LAS float* s = scr + (8 * c) * 33 + n;
        v4u o; o.x = pk2(s[0 * 33], s[1 * 33]); o.y = pk2(s[2 * 33], s[3 * 33]); o.z = pk2(s[4 * 33], s[5 * 33]); o.w = pk2(s[6 * 33], s[7 * 33]);
        *(v4u*)(WT + (size_t)(drow0 + n) * ldt + k0 + 8 * c) = o; }
    LDS_WAIT(); asm volatile("" ::: "memory");
}
constexpr int I_IN = (D / 64) * (2 * DFF / 32), I_DN = (DFF / 64) * (D / 32), I_MI = (D / 64) * (INC / 32), I_MO = (CC / 64) * (D / 32), I_FOLD = 64 * 16, I_B = 16;
constexpr int N_WAVE_ITEMS = 2 * I_IN + 2 * I_DN + I_MI + I_MO + I_FOLD + I_B;
static_assert(N_WAVE_ITEMS % NWAVES == 0, "wave items per block item");
constexpr int N_MOD_ITEMS = NMOD / 64, N_BLOCK_ITEMS = N_MOD_ITEMS + N_WAVE_ITEMS / NWAVES;

__device__ __forceinline__ void p0_wave_item(const Args& a, int r, LAS float* scr, int lane) {
    unsigned char* ws = a.ws;
    for (int l = 0; l < 2; ++l) { if (r < I_IN) { const int nblk = 2 * DFF / 32, kb = r / nblk, nb = r % nblk, n0 = 32 * nb, h = n0 >= DFF ? 1 : 0, j = n0 - h * DFF;
            transpose_item(a.in[I_FWIN] + (size_t)l * D * 2 * DFF, 2 * DFF, (bf16*)(ws + (l ? WS_WIN2 : WS_WIN1)), D, 64 * kb, n0, 256 * (j >> 7) + 128 * h + (j & 127), scr, lane); return; } r -= I_IN; }
    for (int l = 0; l < 2; ++l) { if (r < I_DN) { const int nblk = D / 32, kb = r / nblk, nb = r % nblk;
            transpose_item(a.in[I_FWDN] + (size_t)l * DFF * D, D, (bf16*)(ws + (l ? WS_WDN2 : WS_WDN1)), DFF, 64 * kb, 32 * nb, 32 * nb, scr, lane); return; } r -= I_DN; }
    if (r < I_MI) { const int nblk = INC / 32, kb = r / nblk, nb = r % nblk, n0 = 32 * nb; int drow = n0;
        if (n0 < 1024) { const int h = n0 >= 512 ? 1 : 0, j = n0 - 512 * h; drow = 256 * (j >> 7) + 128 * h + (j & 127); }
        transpose_item(a.in[I_MWIN], INC, (bf16*)(ws + WS_WMI), D, 64 * kb, n0, drow, scr, lane); return; } r -= I_MI;
    if (r < I_MO) { const int nblk = D / 32, kb = r / nblk, nb = r % nblk;
        transpose_item(a.in[I_MWOUT], D, (bf16*)(ws + WS_WMO), D, 64 * kb, 32 * nb, 32 * nb, scr, lane); return; } r -= I_MO;
    const float* wout = a.in[I_MWOUT]; const float* pscale = a.in[I_PSCALE];
    if (r < I_FOLD) {
        const int cg8 = r >> 4, nb = r & 15, g = cg8 >> 4, cg0 = cg8 * 8, n = nb * 64 + lane;
        const float* pw = a.in[I_POOLW] + (size_t)cg0 * 128;
        float acc[8];
#pragma unroll
        for (int e = 0; e < 8; ++e) acc[e] = 0.f;
        for (int d = 0; d < 128; ++d) { const float w = wout[(size_t)(512 + g * 128 + d) * D + n] * pscale[g * 128 + d];
#pragma unroll
            for (int e = 0; e < 8; ++e) acc[e] += pw[e * 128 + d] * w; }
        v4u o; o.x = pk2(acc[0], acc[1]); o.y = pk2(acc[2], acc[3]); o.z = pk2(acc[4], acc[5]); o.w = pk2(acc[6], acc[7]);
        *(v4u*)((bf16*)(ws + WS_WMO) + (size_t)n * D + 512 + cg0) = o; return; } r -= I_FOLD;
    {
        const int n = r * 64 + lane; const float* pb = a.in[I_POOLB]; float acc = a.in[I_MBOUT][n];
        for (int j = 0; j < PC; ++j) acc += pb[j] * pscale[j] * wout[(size_t)(512 + j) * D + n];
        ((float*)(ws + WS_BIAS2))[n] = acc; }
}
__device__ __forceinline__ void p0_mod_item(const Args& a, int item, LAS unsigned char* lds, int tid, int wave, int lane) {
    LAS float* sc = (LAS float*)lds; LAS float* red = (LAS float*)(lds + NBATCH * D * 4);
    for (int idx = tid; idx < NBATCH * D; idx += NTHREADS) { const int b = idx >> 10, k = idx & 1023; const float c = b < NB_P ? a.in[I_CP][b * D + k] : a.in[I_CS][(b - NB_P) * D + k]; sc[idx] = c / (1.0f + __expf(-c)); }
    __syncthreads();
    const int j = item * 64 + lane; const float* aw = a.in[I_ADAW] + j;
    float acc[NBATCH];
#pragma unroll
    for (int b = 0; b < NBATCH; ++b) acc[b] = 0.f;
    for (int k4 = 0; k4 < 32; ++k4) { const int kk = wave * 128 + 4 * k4;
        const float a0 = aw[(size_t)(kk + 0) * NMOD], a1 = aw[(size_t)(kk + 1) * NMOD], a2 = aw[(size_t)(kk + 2) * NMOD], a3 = aw[(size_t)(kk + 3) * NMOD];
#pragma unroll
        for (int b = 0; b < NBATCH; ++b) { const f32x4 s = *(const LAS f32x4*)(sc + b * D + kk); acc[b] += (a0 * s.x + a1 * s.y) + (a2 * s.z + a3 * s.w); } }
#pragma unroll
    for (int b = 0; b < NBATCH; ++b) red[(wave * NBATCH + b) * 64 + lane] = acc[b];
    __syncthreads();
    for (int idx = tid; idx < NBATCH * 64; idx += NTHREADS) { const int b = idx >> 6, l = idx & 63; float s = a.in[I_ADAB][item * 64 + l];
#pragma unroll
        for (int w = 0; w < NWAVES; ++w) s += red[(w * NBATCH + b) * 64 + l];
        ((float*)(a.ws + WS_MOD))[(size_t)b * NMOD + item * 64 + l] = s; }
    __syncthreads();
}

__device__ __forceinline__ void store_mod_row(const f32x4 (&v)[4], const float* MOD, int m, int kmod, bf16* U, int lane) {
    const float* mp = MOD + (size_t)batch_of_row(m) * NMOD + 3 * kmod * D; const f32x4* sh = (const f32x4*)mp + lane; const f32x4* sc = (const f32x4*)(mp + D) + lane;
    v2u* o = (v2u*)(U + (size_t)m * D) + lane;
#pragma unroll
    for (int j = 0; j < 4; ++j) { const f32x4 u = v[j] * (sc[64 * j] + 1.0f) + sh[64 * j]; v2u w; w.x = pk2(u.x, u.y); w.y = pk2(u.z, u.w); o[64 * j] = w; }
}
__device__ __forceinline__ void modulate_phase(const Args& a, int G, int wave, int lane) {
    const float* MOD = (const float*)(a.ws + WS_MOD); bf16* U = (bf16*)(a.ws + WS_U);
    for (int m = blockIdx.x * NWAVES + wave; m < M; m += G * NWAVES) {
        const f32x4* xr = (const f32x4*)(m < M_P ? a.in[I_XP] + (size_t)m * D : a.in[I_XS] + (size_t)(m - M_P) * D) + lane;
        f32x4 v[4];
#pragma unroll
        for (int j = 0; j < 4; ++j) v[j] = xr[64 * j];
        store_mod_row(v, MOD, m, 0, U, lane);
    }
}
__device__ __forceinline__ void ln_phase(const Args& a, int kln, int kmod, int G, int wave, int lane) {
    const float* MOD = (const float*)(a.ws + WS_MOD); bf16* U = (bf16*)(a.ws + WS_U); float* XY = a.out + OUT_Y;
    f32x4 gv[4], bv[4];
#pragma unroll
    for (int j = 0; j < 4; ++j) { gv[j] = ((const f32x4*)(a.in[I_LNG] + kln * D))[lane + 64 * j]; bv[j] = ((const f32x4*)(a.in[I_LNB] + kln * D))[lane + 64 * j]; }
    for (int m = blockIdx.x * NWAVES + wave; m < M; m += G * NWAVES) {
        f32x4* xr = (f32x4*)(XY + (size_t)m * D) + lane;
        f32x4 v[4]; float s = 0.f;
#pragma unroll
        for (int j = 0; j < 4; ++j) { v[j] = xr[64 * j]; s += (v[j].x + v[j].y) + (v[j].z + v[j].w); }
        const float mean = wave_sum(s) * (1.f / D); float s2 = 0.f;
#pragma unroll
        for (int j = 0; j < 4; ++j) { v[j] = v[j] - mean; s2 += (v[j].x * v[j].x + v[j].y * v[j].y) + (v[j].z * v[j].z + v[j].w * v[j].w); }
        const float rstd = 1.f / sqrtf(wave_sum(s2) * (1.f / D) + LN_EPS);
#pragma unroll
        for (int j = 0; j < 4; ++j) { v[j] = v[j] * rstd * gv[j] + bv[j]; xr[64 * j] = v[j]; }
        if (kmod >= 0) store_mod_row(v, MOD, m, kmod, U, lane);
    }
}

template <int CT> __device__ __forceinline__ void convpool_unit(const Args& a, int row0, LAS unsigned char* lds, int tid, int wave, int lane) {
    const float* GLU = (const float*)(a.ws + WS_GLU); const float* ZP = (const float*)(a.ws + WS_ZP); bf16* A2 = (bf16*)(a.ws + WS_U);
    LAS float* tile = (LAS float*)lds;
    const bool samp = row0 >= M_P;
    int b, t0, Tlen, rowbase;
    if (!samp) { b = row0 >> 14; t0 = row0 & (T_P - 1); Tlen = T_P; rowbase = b * T_P; }
    else { const int r = row0 - M_P; b = r >> 6; t0 = r & (T_S - 1); Tlen = T_S; rowbase = M_P + b * T_S; }
    const bool last = (t0 + CT == Tlen);
    const int c = tid, r0 = tid >> 7;
    constexpr int NRC = CT + CH, NITC = (NRC + 3) / 4, NRP = CT + PH, NITP = (NRP + 3) / 4;
    const f32x4* safe = (const f32x4*)GLU + tid;
    f32x4 sv[NITC], pv[NITP];
    {   const f32x4* gp = (const f32x4*)GLU + ((long)(rowbase + t0 - CH) * (CC / 4) + tid);
        const f32x4* cp = (const f32x4*)a.in[I_CCONV] + ((long)(b * CH + t0) * (CC / 4) + tid);
#pragma unroll
        for (int it = 0; it < NITC; ++it) { const int r = r0 + 4 * it, ti = t0 - CH + r; const bool valid = (r < NRC) && (ti >= 0 || samp);
            const f32x4* p = ti >= 0 ? gp + it * 512 : cp + it * 512; p = valid ? p : safe; const f32x4 v = *p;
            sv[it] = valid ? v : (f32x4){0.f, 0.f, 0.f, 0.f}; } }
    {
        f32x4* st4 = (f32x4*)(a.out + (samp ? OUT_SCS : OUT_SCP) + (size_t)b * CH * CC) + tid;
#pragma unroll
        for (int it = 0; it < NITC; ++it) { const int r = r0 + 4 * it;
            if (r < NRC) { *(LAS f32x4*)(tile + (tid + it * 512) * 4) = sv[it]; if (last && r >= CT) st4[(it * 4 - CT) * (CC / 4)] = sv[it]; } }
        __syncthreads();
        float w[CW], acc[CT];
#pragma unroll
        for (int k = 0; k < CW; ++k) w[k] = a.in[I_CONVW][k * CC + c];
        const float cb = a.in[I_CONVB][c];
#pragma unroll
        for (int tt = 0; tt < CT; ++tt) acc[tt] = cb;
        float in[CT + CH];
#pragma unroll
        for (int i = 0; i < CT + CH; ++i) in[i] = tile[i * CC + c];
#pragma unroll
        for (int tt = 0; tt < CT; ++tt) {
#pragma unroll
            for (int k = 0; k < CW; ++k) acc[tt] += w[k] * in[tt + k]; }
#pragma unroll
        for (int tt = 0; tt < CT; ++tt) tile[tt * CC + c] = acc[tt];
    }
    {   const f32x4* gp = (const f32x4*)ZP + ((long)(rowbase + t0 - PH) * (PC / 4) + tid);
        const f32x4* cp = (const f32x4*)a.in[I_CPOOL] + ((long)(b * PH + t0) * (PC / 4) + tid);
#pragma unroll
        for (int it = 0; it < NITP; ++it) { const int r = r0 + 4 * it, ti = t0 - PH + r; const bool valid = (r < NRP) && (ti >= 0 || samp);
            const f32x4* p = ti >= 0 ? gp + it * 512 : cp + it * 512; p = valid ? p : safe; const f32x4 v = *p;
            pv[it] = valid ? v : (f32x4){0.f, 0.f, 0.f, 0.f}; } }
    __syncthreads();
    {
        const f32x4 g0 = ((const f32x4*)a.in[I_CLNG])[lane], g1 = ((const f32x4*)a.in[I_CLNG])[64 + lane], b0 = ((const f32x4*)a.in[I_CLNB])[lane], b1 = ((const f32x4*)a.in[I_CLNB])[64 + lane];
#pragma unroll
        for (int q = 0; q < CT / NWAVES; ++q) { const int tt = wave * (CT / NWAVES) + q;
            f32x4 v0 = *(const LAS f32x4*)(tile + tt * CC + 4 * lane), v1 = *(const LAS f32x4*)(tile + tt * CC + 256 + 4 * lane);
            const float mean = wave_sum((v0.x + v0.y) + (v0.z + v0.w) + (v1.x + v1.y) + (v1.z + v1.w)) * (1.f / CC);
            v0 = v0 - mean; v1 = v1 - mean;
            const float var = wave_sum((v0.x * v0.x + v0.y * v0.y) + (v0.z * v0.z + v0.w * v0.w) + (v1.x * v1.x + v1.y * v1.y) + (v1.z * v1.z + v1.w * v1.w)) * (1.f / CC);
            const float rstd = 1.f / sqrtf(var + LN_EPS);
            v0 = v0 * rstd * g0 + b0; v1 = v1 * rstd * g1 + b1;
            v2u w0, w1; w0.x = pk2(pg8::silu_f(v0.x), pg8::silu_f(v0.y)); w0.y = pk2(pg8::silu_f(v0.z), pg8::silu_f(v0.w));
            w1.x = pk2(pg8::silu_f(v1.x), pg8::silu_f(v1.y)); w1.y = pk2(pg8::silu_f(v1.z), pg8::silu_f(v1.w));
            bf16* op = A2 + (size_t)(row0 + tt) * D;
            *(v2u*)(op + 4 * lane) = w0; *(v2u*)(op + 256 + 4 * lane) = w1; }
    }
    __syncthreads();
    {
        f32x4* st4 = (f32x4*)(a.out + (samp ? OUT_SPS : OUT_SPP) + (size_t)b * PH * PC) + tid;
#pragma unroll
        for (int it = 0; it < NITP; ++it) { const int r = r0 + 4 * it;
            if (r < NRP) { *(LAS f32x4*)(tile + (tid + it * 512) * 4) = pv[it]; if (last && r >= CT) st4[(it * 4 - CT) * (PC / 4)] = pv[it]; } }
        __syncthreads();
        const int g = c >> 7, wnd = 2 << g;
        float in[CT + PH], s2[CT + PH], s4[CT + PH], s8[CT + PH];
        bf16* op = A2 + (size_t)row0 * D + 512 + c;
#pragma unroll
        for (int i = 0; i < CT + PH; ++i) { in[i] = tile[i * PC + c];
            s2[i] = in[i] + (i >= 1 ? in[i - 1] : 0.f); s4[i] = s2[i] + (i >= 2 ? s2[i - 2] : 0.f); s8[i] = s4[i] + (i >= 4 ? s4[i - 4] : 0.f);
            const float s16 = s8[i] + (i >= 8 ? s8[i - 8] : 0.f);
            if (i >= PH) { const int tt = i - PH; const float wsum = g == 0 ? s2[i] : g == 1 ? s4[i] : g == 2 ? s8[i] : s16;
                const int pos = (samp ? PAST : 0) + t0 + tt; const int cnt = pos + 1 < wnd ? pos + 1 : wnd;
                const float pooled = wsum / (float)cnt - in[i];
                op[(size_t)tt * D] = (bf16)(pk2(pooled, 0.f) & 0xffffu); } }
    }
    __syncthreads();
}

__global__ void __launch_bounds__(NTHREADS, 2) mk_fwd(Args a) {
    extern __shared__ __attribute__((aligned(16))) unsigned char lds_raw[];
    LAS unsigned char* lds = (LAS unsigned char*)lds_raw;
    const int tid0 = threadIdx.x, G = gridDim.x;
#define PHASE_IDS int tid = threadIdx.x; asm volatile("" : "+v"(tid)); const int lane = tid & 63, wave = __builtin_amdgcn_readfirstlane(tid >> 6)
    const int lo = a.ph_lo, hi = a.ph_hi;
    unsigned char* ws = a.ws;
    const float* MOD = (const float*)(ws + WS_MOD);
    bf16* U = (bf16*)(ws + WS_U); bf16* ACT = (bf16*)(ws + WS_ACT);
    float* XY = a.out + OUT_Y;
#define IN(k) (lo <= (k) && (k) < hi)
#define SEAM(k) do { if (IN(k) && IN((k) + 1)) xcd_barrier(bar); } while (0)
#if defined(PROBE_PHASE)
    unsigned long long ts_a = 0, ts_b = 0;
#define STAMP(k) do { if ((k) == PROBE_PHASE) ts_a = rt(); if ((k) == PROBE_PHASE + 1) ts_b = rt(); } while (0)
#else
#define STAMP(k) do {} while (0)
#endif

    for (int u = tid0; u < (LDS_BYTES - RING_BYTES) / 4; u += NTHREADS) ((LAS unsigned*)(lds + RING_BYTES))[u] = 0u;
    __syncthreads();
    if (lo < 0) cg::this_grid().sync();
    XcdBarrier bar; bar.bar = (unsigned*)(ws + WS_CTL) + CW_BAR; bar.x = 0; bar.st = nullptr;
    if (hi - lo > 1) bar = xcd_barrier_post((unsigned*)(ws + WS_CTL) + CW_BAR, (volatile LAS unsigned*)(lds + MISC_OFF + 32));
    STAMP(0); if (IN(0)) { PHASE_IDS;
        for (int bi = blockIdx.x; bi < N_BLOCK_ITEMS; bi += G) {
            if (bi < N_MOD_ITEMS) p0_mod_item(a, bi, lds, tid, wave, lane);
            else p0_wave_item(a, (bi - N_MOD_ITEMS) * NWAVES + wave, (LAS float*)(lds + wave * 16384), lane);
        }
    }
    SEAM(0);
    STAMP(1); if (IN(1)) { PHASE_IDS; (void)tid; modulate_phase(a, G, wave, lane); }
    SEAM(1);
    STAMP(2); if (IN(2)) { pg8::Gemm g{U, (const bf16*)(ws + WS_WIN1), M, 2 * DFF, D}; pg8::StaticOrder S; S.init(M, 2 * DFF, G, (int)blockIdx.x);
        pg8::EpiSwiGLU E{ACT, DFF}; pg8::gemm_phase<pg8::EpiSwiGLU, pg8::StaticOrder, true, true>(lds, g, S, E); }
    SEAM(2);
    STAMP(3); if (IN(3)) { pg8::Gemm g{ACT, (const bf16*)(ws + WS_WDN1), M, D, DFF}; pg8::StaticOrder S; S.init(M, D, G, (int)blockIdx.x);
        pg8::EpiResid E{a.in[I_XP], a.in[I_XS], XY, MOD + 2 * D, nullptr, 0.5f}; pg8::gemm_phase<pg8::EpiResid, pg8::StaticOrder, true, true>(lds, g, S, E); }
    SEAM(3);
    STAMP(4); if (IN(4)) { PHASE_IDS; (void)tid; ln_phase(a, 0, 1, G, wave, lane); }
    SEAM(4);
    STAMP(5); if (IN(5)) { pg8::Gemm g{U, (const bf16*)(ws + WS_WMI), M, INC, D}; pg8::StaticOrder S; S.init(M, INC, G, (int)blockIdx.x);
        pg8::EpiMixIn E{(float*)(ws + WS_GLU), (float*)(ws + WS_ZP), a.in[I_MBIN]}; pg8::gemm_phase<pg8::EpiMixIn, pg8::StaticOrder, true, true>(lds, g, S, E); }
    SEAM(5);
    STAMP(6); if (IN(6)) { PHASE_IDS; for (int u = blockIdx.x; u < M_P / 32 + M_S / 8; u += G) { if (u < M_P / 32) convpool_unit<32>(a, u * 32, lds, tid, wave, lane); else convpool_unit<8>(a, M_P + (u - M_P / 32) * 8, lds, tid, wave, lane); } }
    SEAM(6);
    STAMP(7); if (IN(7)) { pg8::Gemm g{U, (const bf16*)(ws + WS_WMO), M, D, D}; pg8::StaticOrder S; S.init(M, D, G, (int)blockIdx.x);
        pg8::EpiResid E{XY, XY + (size_t)M_P * D, XY, MOD + 5 * D, (const float*)(ws + WS_BIAS2), 1.0f}; pg8::gemm_phase<pg8::EpiResid, pg8::StaticOrder, true, true>(lds, g, S, E); }
    SEAM(7);
    STAMP(8); if (IN(8)) { PHASE_IDS; (void)tid; ln_phase(a, 1, 2, G, wave, lane); }
    SEAM(8);
    STAMP(9); if (IN(9)) { pg8::Gemm g{U, (const bf16*)(ws + WS_WIN2), M, 2 * DFF, D}; pg8::StaticOrder S; S.init(M, 2 * DFF, G, (int)blockIdx.x);
        pg8::EpiSwiGLU E{ACT, DFF}; pg8::gemm_phase<pg8::EpiSwiGLU, pg8::StaticOrder, true, true>(lds, g, S, E); }
    SEAM(9);
    STAMP(10); if (IN(10)) { pg8::Gemm g{ACT, (const bf16*)(ws + WS_WDN2), M, D, DFF}; pg8::StaticOrder S; S.init(M, D, G, (int)blockIdx.x);
        pg8::EpiResid E{XY, XY + (size_t)M_P * D, XY, MOD + 8 * D, nullptr, 0.5f}; pg8::gemm_phase<pg8::EpiResid, pg8::StaticOrder, true, true>(lds, g, S, E); }
    SEAM(10);
    STAMP(11); if (IN(11)) { PHASE_IDS; (void)tid; ln_phase(a, 2, -1, G, wave, lane); }
    STAMP(12);
#if defined(PROBE_PHASE)
    if (blockIdx.x == 0 && threadIdx.x == 0) { const unsigned long long dur = (ts_b - ts_a) * 4ull; const unsigned long long t0 = rt(); while (rt() - t0 < dur) __builtin_amdgcn_s_sleep(32); }
#endif
#undef IN
#undef SEAM
}

extern "C" void kernel_launch(void* const* d_in, const int* in_sizes, int n_in, void* d_out, int out_size, void* d_ws, size_t ws_size, hipStream_t stream) {
    static int grid = 0;
    if (grid == 0) {
        if (n_in != 23 || in_sizes[0] != M_P * D || in_sizes[1] != M_S * D || (size_t)out_size != OUT_END || ws_size < WS_END) {
            fprintf(stderr, "kernel_launch: unexpected shapes (n_in %d, in0 %d, out %d, ws %zu); nothing launched\n", n_in, n_in > 0 ? in_sizes[0] : -1, out_size, ws_size); grid = -1; return; }
        int dev = 0, cus = 0, per_cu = 0;
        if (hipGetDevice(&dev) != hipSuccess || hipDeviceGetAttribute(&cus, hipDeviceAttributeMultiprocessorCount, dev) != hipSuccess) { fprintf(stderr, "kernel_launch: device query failed\n"); grid = -1; return; }
        if (hipFuncSetAttribute((const void*)mk_fwd, hipFuncAttributeMaxDynamicSharedMemorySize, LDS_BYTES) != hipSuccess) { fprintf(stderr, "kernel_launch: hipFuncSetAttribute failed\n"); grid = -1; return; }
        if (hipOccupancyMaxActiveBlocksPerMultiprocessor(&per_cu, (const void*)mk_fwd, NTHREADS, LDS_BYTES) != hipSuccess || per_cu < 1) { per_cu = 1; (void)hipGetLastError(); }
        grid = cus * per_cu;
    }
    if (grid < 0) return;
    if (hipMemsetAsync((char*)d_ws + WS_CTL, 0, CTL_ZERO_BYTES, stream) != hipSuccess) { fprintf(stderr, "kernel_launch: memset failed\n"); return; }
    Args a{};
    for (int i = 0; i < 23; ++i) a.in[i] = (const float*)d_in[i];
    a.out = (float*)d_out; a.ws = (unsigned char*)d_ws;
    if (N_LAUNCHES == 1) {
        a.ph_lo = 0; a.ph_hi = NPHASE;
        void* kargs[] = {&a};
        const hipError_t e = hipLaunchCooperativeKernel((const void*)mk_fwd, dim3(grid), dim3(NTHREADS), kargs, LDS_BYTES, stream);
        if (e != hipSuccess) fprintf(stderr, "kernel_launch: cooperative launch failed: %s (grid %d)\n", hipGetErrorString(e), grid);
    } else {
        for (int p = 0; p < NPHASE; ++p) { a.ph_lo = p; a.ph_hi = p + 1; hipLaunchKernelGGL(mk_fwd, dim3(grid), dim3(NTHREADS), LDS_BYTES, stream, a); }
    }
}
```

```cpp
#include <hip/hip_runtime.h>
#include <hip/hip_cooperative_groups.h>
#include <cstdio>
#include <cstdint>
namespace cg = cooperative_groups;

constexpr int D = 1024, DFF = 2816, T_P = 16384, NB_P = 2, T_S = 64, NB_S = 16;
constexpr int M_P = NB_P * T_P, M_S = NB_S * T_S, M = M_P + M_S;
constexpr int NBATCH = NB_P + NB_S, NMOD = 9 * D;
constexpr int CC = 512, PC = 512, INC = 1536, CW = 31, CH = 30, PH = 15, PAST = 4096;
constexpr float LN_EPS = 1e-5f;
constexpr float ALPHA = 1.189207115002721f;
constexpr size_t OUT_Y = 0, OUT_SCP = (size_t)M * D, OUT_SPP = OUT_SCP + (size_t)NB_P * CH * CC, OUT_SCS = OUT_SPP + (size_t)NB_P * PH * PC,
                 OUT_SPS = OUT_SCS + (size_t)NB_S * CH * CC, OUT_END = OUT_SPS + (size_t)NB_S * PH * PC;
constexpr size_t MiB = 1u << 20;
constexpr size_t WS_CTL = 0, WS_MOD = 1 * MiB, WS_BIAS2 = 1 * MiB + 768 * 1024;
constexpr size_t WS_WIN1 = 2 * MiB, WS_WIN2 = 13 * MiB, WS_WDN1 = 24 * MiB, WS_WDN2 = 30 * MiB, WS_WMI = 36 * MiB, WS_WMO = 39 * MiB;
constexpr size_t WS_U = 48 * MiB;
constexpr size_t WS_ACT = 114 * MiB;
constexpr size_t WS_GLU = WS_ACT, WS_ZP = WS_ACT + 66 * MiB;
constexpr size_t WS_PART = 296 * MiB;
constexpr size_t WS_END = 340 * MiB;
static_assert((size_t)NBATCH * NMOD * 4 <= 768 * 1024, "mod");
static_assert(WS_U + (size_t)M * D * 2 <= WS_ACT && WS_ACT + (size_t)M * DFF * 2 <= WS_PART && WS_ZP + (size_t)M * PC * 4 <= WS_PART && WS_PART + (size_t)11 * M_S * D * 4 <= WS_END, "ws map");
static_assert((size_t)M * CC * 4 == 66 * MiB, "glu size");

__device__ __forceinline__ int batch_of_row(int r) { return r < M_P ? (r >> 14) : NB_P + ((r - M_P) >> 6); }

namespace pg8 {
#define PG8_LAS __attribute__((address_space(3)))
typedef unsigned short bf16_t;
typedef short bf16x8 __attribute__((ext_vector_type(8)));
typedef float f32x4 __attribute__((ext_vector_type(4)));
typedef unsigned u32x4 __attribute__((ext_vector_type(4)));
constexpr int BM = 256, BK = 64, HALF = 128, HTB = HALF * BK * 2  , STAGE_BYTES = 8 * HTB, NXCD = 8, WGM = 8;

__host__ __device__ __forceinline__ int lds_byte(int r, int c) { const int st = (r >> 4) * 2 + (c >> 5), rr = r & 15, cc = c & 31, ob = rr * 64 + cc * 2; return st * 1024 + (ob ^ (((ob >> 9) & 1) << 5)); }
__host__ __device__ __forceinline__ void stage_rc(int b, int& R, int& C) { const int st = b / 1024, sb = b % 1024, swz = sb ^ (((sb >> 9) & 1) << 5); R = (st >> 1) * 16 + swz / 64; C = (st & 1) * 32 + (swz % 64) / 2; }
__host__ __device__ __forceinline__ int perm32(int rho) { const int n = rho >> 4, i = rho & 15; return 8 * (i >> 2) + 4 * n + (i & 3); }

struct Unit { int pm, pn, ko; };
struct Gemm { const bf16_t* A; const bf16_t* Bt; int M, N, K, ld; };

struct StaticOrder {
    int nM, nN, nwg, G, c;
    __host__ __device__ void init(int M, int N, int G_, int c_) { nM = M / BM; nN = N / BM; nwg = nM * nN; G = G_; c = c_; }
    __host__ __device__ bool next(int i, Unit& u) const {
        const long L = (long)i * G + c; if (L >= nwg) return false;
        int wgid = (int)L; { const int q = nwg / NXCD, r = nwg % NXCD, xcd = wgid % NXCD, off = wgid / NXCD; wgid = (xcd < r ? xcd * (q + 1) : r * (q + 1) + (xcd - r) * q) + off; }
        const int nig = WGM * nN, gid = wgid / nig, fm = gid * WGM, gsz = (nM - fm) < WGM ? (nM - fm) : WGM;
        u.pm = fm + ((wgid % nig) % gsz); u.pn = (wgid % nig) / gsz; u.ko = 0; return true;
    }
    __device__ __forceinline__ void a_ready(const Unit&) const {}
    __device__ __forceinline__ void done(const Unit&) const {}
};
struct SplitOrder {
    int nM, nN, nks, ksz, G, c;
    __host__ __device__ void init(int M, int N, int nks_, int ksz_, int G_, int c_) { nM = M / BM; nN = N / BM; nks = nks_; ksz = ksz_; G = G_; c = c_; }
    __host__ __device__ bool next(int i, Unit& u) const {
        const int n = nM * nN * nks; const long L = (long)i * G + c; int id;
        if (G % NXCD == 0) { const int per = (n + NXCD - 1) / NXCD, x = (int)(L % NXCD), idx = (int)(L / NXCD); if (idx >= per) return false; id = x * per + idx; } else id = (int)L;
        if (id >= n) return false;
        u.pm = id % nM; const int r = id / nM; u.ko = (r % nks) * ksz; u.pn = r / nks; return true;
    }
    __device__ __forceinline__ void a_ready(const Unit&) const {}
    __device__ __forceinline__ void done(const Unit&) const {}
};

__device__ __forceinline__ unsigned cvt_pk_bf16(float lo, float hi) { unsigned r; asm volatile("v_cvt_pk_bf16_f32 %0, %1, %2" : "=v"(r) : "v"(lo), "v"(hi)); return r; }
__device__ __forceinline__ float sigmoid_f(float g) { return __builtin_amdgcn_rcpf(1.0f + __expf(-g)); }
__device__ __forceinline__ float silu_f(float g) { return g * sigmoid_f(g); }

struct EpiSwiGLU {
    static constexpr bool PERM = true, AFTER_DRAIN = false;
    bf16_t* O; int ldc;
    __device__ __forceinline__ void operator()(const f32x4 (&acc)[2][2][4][2], const Unit& u, int wr, int wc, int fr, int fq) const {
        const int row0 = u.pm * BM + wr * 64 + fr, col0 = u.pn * HALF + wc * 32 + 8 * fq;
#pragma unroll
        for (int ai = 0; ai < 2; ++ai)
#pragma unroll
            for (int m = 0; m < 4; ++m) { bf16_t* rowp = O + (size_t)(row0 + ai * HALF + m * 16) * ldc + col0;
                const f32x4 g0 = acc[ai][0][m][0], g1 = acc[ai][0][m][1], v0 = acc[ai][1][m][0], v1 = acc[ai][1][m][1];
                f32x4 h0, h1;
#pragma unroll
                for (int e = 0; e < 4; ++e) { h0[e] = silu_f(g0[e]) * v0[e]; h1[e] = silu_f(g1[e]) * v1[e]; }
                u32x4 w; w.x = cvt_pk_bf16(h0[0], h0[1]); w.y = cvt_pk_bf16(h0[2], h0[3]); w.z = cvt_pk_bf16(h1[0], h1[1]); w.w = cvt_pk_bf16(h1[2], h1[3]);
                *(u32x4*)rowp = w; }
    }
};

struct EpiMixIn {
    static constexpr bool PERM = false, AFTER_DRAIN = false;
    float* GLU; float* ZP; const float* bias;
    __device__ __forceinline__ void operator()(const f32x4 (&acc)[2][2][4][2], const Unit& u, int wr, int wc, int fr, int fq) const {
        const int row0 = u.pm * BM + wr * 64 + fr;
        if (u.pn < 4) {
            const int cb = u.pn * HALF + wc * 32 + 4 * fq;
            f32x4 ba[2], bb[2];
#pragma unroll
            for (int n = 0; n < 2; ++n) { ba[n] = *(const f32x4*)(bias + cb + 16 * n); bb[n] = *(const f32x4*)(bias + 512 + cb + 16 * n); }
#pragma unroll
            for (int ai = 0; ai < 2; ++ai)
#pragma unroll
                for (int m = 0; m < 4; ++m) { float* rowp = GLU + (size_t)(row0 + ai * HALF + m * 16) * CC + cb;
#pragma unroll
                    for (int n = 0; n < 2; ++n) { const f32x4 za = acc[ai][0][m][n] + ba[n], zb = acc[ai][1][m][n] + bb[n]; f32x4 o;
#pragma unroll
                        for (int e = 0; e < 4; ++e) o[e] = za[e] * sigmoid_f(zb[e]);
                        *(f32x4*)(rowp + 16 * n) = o; } }
        } else {
            const int cb = (u.pn - 4) * BM + wc * 32 + 4 * fq;
            f32x4 bv[2][2];
#pragma unroll
            for (int bj = 0; bj < 2; ++bj)
#pragma unroll
                for (int n = 0; n < 2; ++n) bv[bj][n] = *(const f32x4*)(bias + 1024 + cb + bj * HALF + 16 * n);
#pragma unroll
            for (int ai = 0; ai < 2; ++ai)
#pragma unroll
                for (int m = 0; m < 4; ++m) { float* rowp = ZP + (size_t)(row0 + ai * HALF + m * 16) * PC + cb;
#pragma unroll
                    for (int bj = 0; bj < 2; ++bj)
#pragma unroll
                        for (int n = 0; n < 2; ++n) *(f32x4*)(rowp + bj * HALF + 16 * n) = acc[ai][bj][m][n] + bv[bj][n]; }
        }
    }
};

struct EpiResid {
    static constexpr bool PERM = false, AFTER_DRAIN = false;
    const float* res_p; const float* res_s; float* out; const float* gate; const float* bias; float gs;
    __device__ __forceinline__ void operator()(const f32x4 (&acc)[2][2][4][2], const Unit& u, int wr, int wc, int fr, int fq) const {
        const int c0 = u.pn * BM + wc * 32 + 4 * fq;
#pragma unroll
        for (int ai = 0; ai < 2; ++ai) {
            const int rbase = u.pm * BM + ai * HALF + wr * 64;
            const float* gp = gate + (size_t)batch_of_row(rbase) * NMOD + c0;
            f32x4 gv[2][2], bv[2][2];
#pragma unroll
            for (int bj = 0; bj < 2; ++bj)
#pragma unroll
                for (int n = 0; n < 2; ++n) { gv[bj][n] = *(const f32x4*)(gp + bj * HALF + 16 * n) * gs;
                    bv[bj][n] = bias ? *(const f32x4*)(bias + c0 + bj * HALF + 16 * n) : (f32x4){0.f, 0.f, 0.f, 0.f}; }
#pragma unroll
            for (int m = 0; m < 4; ++m) { const int r = rbase + m * 16 + fr;
                const float* rp = (r < M_P ? res_p + (size_t)r * D : res_s + (size_t)(r - M_P) * D) + c0; float* op = out + (size_t)r * D + c0;
#pragma unroll
                for (int bj = 0; bj < 2; ++bj)
#pragma unroll
                    for (int n = 0; n < 2; ++n) { const f32x4 x = *(const f32x4*)(rp + bj * HALF + 16 * n);
                        *(f32x4*)(op + bj * HALF + 16 * n) = x * ALPHA + gv[bj][n] * (acc[ai][bj][m][n] + bv[bj][n]); } }
        }
    }
};

struct EpiPartial {
    static constexpr bool PERM = false, AFTER_DRAIN = false;
    float* P; int ksz; size_t slab;
    __device__ __forceinline__ void operator()(const f32x4 (&acc)[2][2][4][2], const Unit& u, int wr, int wc, int fr, int fq) const {
        float* base = P + (size_t)(u.ko / ksz) * slab + (size_t)(u.pm * BM + wr * 64 + fr) * D + u.pn * BM + wc * 32 + 4 * fq;
#pragma unroll
        for (int ai = 0; ai < 2; ++ai)
#pragma unroll
            for (int m = 0; m < 4; ++m) { float* rowp = base + (size_t)(ai * HALF + m * 16) * D;
#pragma unroll
                for (int bj = 0; bj < 2; ++bj)
#pragma unroll
                    for (int n = 0; n < 2; ++n) *(f32x4*)(rowp + bj * HALF + 16 * n) = acc[ai][bj][m][n]; }
    }
};

template <class Epi, class Sched, bool ALIGN_EPI = false, bool SP2 = false>
__device__ __forceinline__ void gemm_phase(PG8_LAS unsigned char* lds, const Gemm g, const Sched& S, const Epi& E) {
    const int tid = threadIdx.x, wid = __builtin_amdgcn_readfirstlane(tid >> 6), lane = tid & 63, wr = wid >> 2, wc = wid & 3, fr = lane & 15, fq = lane >> 4;
    const int K = g.K, nt = K / BK;
    unsigned voffA[2], voffB[2];
#pragma unroll
    for (int i = 0; i < 2; ++i) { int R, C; stage_rc(tid * 16 + i * 8192, R, C); const int Rb = Epi::PERM ? ((R & ~31) + perm32(R & 31)) : R;
        voffA[i] = (unsigned)(R * g.ld + C) * 2u; voffB[i] = (unsigned)(Rb * g.ld + C) * 2u; }
    const size_t kstep = (size_t)(BK * 2);
    const size_t hstep = (size_t)HALF * g.ld * 2;
    const size_t tstep = 2 * hstep;
    const unsigned ldsw = (unsigned)wid * 1024u;
    const int aoff = lds_byte(wr * 64 + fr, fq * 8), boff = lds_byte(wc * 32 + fr, fq * 8);
#define PG8_SA(b, h) (((b) * 2 + (h)) * HTB)
#define PG8_SB(b, h) ((4 + (b) * 2 + (h)) * HTB)
#define PG8_STAGE(bufoff, gbase, voff) do { _Pragma("unroll") for (int _i = 0; _i < 2; ++_i) \
        __builtin_amdgcn_global_load_lds((const unsigned*)((const char*)(gbase) + (voff)[_i]), (PG8_LAS unsigned*)(lds + (bufoff) + ldsw + _i * 8192), 16, 0, 0); } while (0)
#define PG8_LDA(dst, b, h) do { _Pragma("unroll") for (int m = 0; m < 4; ++m) _Pragma("unroll") for (int k = 0; k < 2; ++k) dst[m][k] = *(const PG8_LAS bf16x8*)(lds + PG8_SA(b, h) + aoff + m * 2048 + k * 1024); } while (0)
#define PG8_LDB(dst, b, h) do { _Pragma("unroll") for (int n = 0; n < 2; ++n) _Pragma("unroll") for (int k = 0; k < 2; ++k) dst[n][k] = *(const PG8_LAS bf16x8*)(lds + PG8_SB(b, h) + boff + n * 2048 + k * 1024); } while (0)
#define PG8_MMA(ai, bj, At, Bt) do { __builtin_amdgcn_s_setprio(1); _Pragma("unroll") for (int m = 0; m < 4; ++m) _Pragma("unroll") for (int n = 0; n < 2; ++n) _Pragma("unroll") for (int k = 0; k < 2; ++k) \
        acc[ai][bj][m][n] = __builtin_amdgcn_mfma_f32_16x16x32_bf16(Bt[n][k], At[m][k], acc[ai][bj][m][n], 0, 0, 0); __builtin_amdgcn_s_setprio(0); } while (0)
#define PG8_WAIT_V(n) asm volatile("s_waitcnt vmcnt(" #n ")" ::: "memory")
#define PG8_WAIT_L(n) asm volatile("s_waitcnt lgkmcnt(" #n ")" ::: "memory")
#define PG8_BAR __builtin_amdgcn_s_barrier()
#define PG8_SCHED __builtin_amdgcn_sched_barrier(0)
    Unit cur, nxt; int ui = 0;
    if (!S.next(0, cur)) return;
    f32x4 acc[2][2][4][2];
#pragma unroll
    for (int a = 0; a < 2; ++a)
#pragma unroll
        for (int b = 0; b < 2; ++b)
#pragma unroll
            for (int m = 0; m < 4; ++m)
#pragma unroll
                for (int n = 0; n < 2; ++n) acc[a][b][m][n] = (f32x4){0.f, 0.f, 0.f, 0.f};
    bf16x8 At[4][2], B0[2][2], B1[2][2];
    const char* cA = (const char*)g.A + (size_t)cur.pm * tstep + (size_t)cur.ko * 2; const char* cB = (const char*)g.Bt + (size_t)cur.pn * tstep + (size_t)cur.ko * 2;
    S.a_ready(cur);
    if constexpr (SP2) {
        PG8_STAGE(PG8_SB(0, 0), cB, voffB); PG8_STAGE(PG8_SB(0, 1), cB + hstep, voffB); PG8_STAGE(PG8_SA(0, 0), cA, voffA); PG8_STAGE(PG8_SA(0, 1), cA + hstep, voffA);
        if (wr == 1) PG8_BAR;
        PG8_WAIT_V(2); PG8_BAR;
        PG8_STAGE(PG8_SB(1, 0), cB + kstep, voffB); PG8_STAGE(PG8_SA(1, 0), cA + kstep, voffA); PG8_STAGE(PG8_SB(1, 1), cB + hstep + kstep, voffB);
        PG8_WAIT_V(6); PG8_BAR;
    } else {
        PG8_STAGE(PG8_SB(0, 0), cB, voffB); PG8_STAGE(PG8_SA(0, 0), cA, voffA); PG8_STAGE(PG8_SB(0, 1), cB + hstep, voffB); PG8_STAGE(PG8_SA(0, 1), cA + hstep, voffA);
        if (wr == 1) PG8_BAR;
        PG8_WAIT_V(4); PG8_BAR;
        PG8_STAGE(PG8_SB(1, 0), cB + kstep, voffB); PG8_STAGE(PG8_SA(1, 0), cA + kstep, voffA); PG8_STAGE(PG8_SB(1, 1), cB + hstep + kstep, voffB);
        PG8_WAIT_V(6); PG8_BAR;
    }
    for (;;) {
        const bool has_next = S.next(ui + 1, nxt);
        const char* nA = has_next ? (const char*)g.A + (size_t)nxt.pm * tstep + (size_t)nxt.ko * 2 : cA; const char* nB = has_next ? (const char*)g.Bt + (size_t)nxt.pn * tstep + (size_t)nxt.ko * 2 : cB;
        for (int t = 0; t < nt; t += 2) {
            const bool last = (t == nt - 2);
            const char* a1 = cA + (size_t)(t + 1) * kstep;
            const char* a2 = last ? nA : cA + (size_t)(t + 2) * kstep; const char* b2 = last ? nB : cB + (size_t)(t + 2) * kstep;
            const char* a3 = a2 + kstep; const char* b3 = b2 + kstep;
            if (last && has_next) S.a_ready(nxt);
            if constexpr (SP2) {
            PG8_LDB(B0, 0, 0); PG8_LDB(B1, 0, 1); PG8_SCHED; PG8_LDA(At, 0, 0); PG8_STAGE(PG8_SA(1, 1), a1 + hstep, voffA);
            PG8_WAIT_V(8); PG8_WAIT_L(0); PG8_BAR; PG8_MMA(0, 0, At, B0); PG8_MMA(0, 1, At, B1); PG8_BAR; PG8_SCHED;
            PG8_LDA(At, 0, 1); PG8_STAGE(PG8_SB(0, 0), b2, voffB); PG8_STAGE(PG8_SB(0, 1), b2 + hstep, voffB); PG8_STAGE(PG8_SA(0, 0), a2, voffA);
            PG8_WAIT_V(8); PG8_WAIT_L(0); PG8_BAR; PG8_MMA(1, 0, At, B0); PG8_MMA(1, 1, At, B1); PG8_BAR; PG8_SCHED;
            PG8_LDB(B0, 1, 0); PG8_LDB(B1, 1, 1); PG8_SCHED; PG8_LDA(At, 1, 0); PG8_STAGE(PG8_SA(0, 1), a2 + hstep, voffA);
            PG8_WAIT_V(8); PG8_WAIT_L(0); PG8_BAR; PG8_MMA(0, 0, At, B0); PG8_MMA(0, 1, At, B1); PG8_BAR; PG8_SCHED;
            PG8_LDA(At, 1, 1); PG8_STAGE(PG8_SB(1, 0), b3, voffB); PG8_STAGE(PG8_SB(1, 1), b3 + hstep, voffB); PG8_STAGE(PG8_SA(1, 0), a3, voffA);
            PG8_WAIT_V(8); PG8_WAIT_L(0); PG8_BAR; PG8_MMA(1, 0, At, B0); PG8_MMA(1, 1, At, B1); PG8_BAR; PG8_SCHED;
            } else {
            PG8_LDB(B0, 0, 0); PG8_SCHED; PG8_LDA(At, 0, 0); PG8_STAGE(PG8_SA(1, 1), a1 + hstep, voffA);
            PG8_WAIT_L(8); PG8_BAR; PG8_WAIT_L(0); PG8_MMA(0, 0, At, B0); PG8_BAR; PG8_SCHED;
            PG8_LDB(B1, 0, 1); PG8_STAGE(PG8_SB(0, 0), b2, voffB);
            PG8_BAR; PG8_WAIT_L(0); PG8_MMA(0, 1, At, B1); PG8_BAR;
            PG8_LDA(At, 0, 1); PG8_STAGE(PG8_SA(0, 0), a2, voffA);
            PG8_BAR; PG8_WAIT_L(0); PG8_MMA(1, 0, At, B0); PG8_BAR; PG8_SCHED;
            PG8_STAGE(PG8_SB(0, 1), b2 + hstep, voffB);
            PG8_WAIT_V(6); PG8_BAR; PG8_MMA(1, 1, At, B1); PG8_BAR;
            PG8_LDB(B0, 1, 0); PG8_SCHED; PG8_LDA(At, 1, 0); PG8_STAGE(PG8_SA(0, 1), a2 + hstep, voffA);
            PG8_WAIT_L(8); PG8_BAR; PG8_WAIT_L(0); PG8_MMA(0, 0, At, B0); PG8_BAR; PG8_SCHED;
            PG8_LDB(B1, 1, 1); PG8_STAGE(PG8_SB(1, 0), b3, voffB);
            PG8_BAR; PG8_WAIT_L(0); PG8_MMA(0, 1, At, B1); PG8_BAR;
            PG8_LDA(At, 1, 1); PG8_STAGE(PG8_SA(1, 0), a3, voffA);
            PG8_BAR; PG8_WAIT_L(0); PG8_MMA(1, 0, At, B0); PG8_BAR; PG8_SCHED;
            PG8_STAGE(PG8_SB(1, 1), b3 + hstep, voffB);
            PG8_WAIT_V(6); PG8_BAR; PG8_MMA(1, 1, At, B1); PG8_BAR;
            }
        }
        if constexpr (ALIGN_EPI) { if (wr == 0) PG8_BAR; }
        if constexpr (!Epi::AFTER_DRAIN) { E(acc, cur, wr, wc, fr, fq); S.done(cur); }
        if (!has_next) break;
#pragma unroll
        for (int a = 0; a < 2; ++a)
#pragma unroll
            for (int b = 0; b < 2; ++b)
#pragma unroll
                for (int m = 0; m < 4; ++m)
#pragma unroll
                    for (int n = 0; n < 2; ++n) acc[a][b][m][n] = (f32x4){0.f, 0.f, 0.f, 0.f};
        cur = nxt; cA = nA; cB = nB; ++ui;
        if constexpr (ALIGN_EPI) { if (wr == 1) PG8_BAR; }
    }
    PG8_WAIT_V(0);
    if constexpr (!ALIGN_EPI) { if (wr == 0) PG8_BAR; }
    PG8_BAR;
    if constexpr (Epi::AFTER_DRAIN) { E.fused(acc, cur, wr, wc, fr, fq, lds, wid, lane); S.done(cur); }
#undef PG8_SA
#undef PG8_SB
#undef PG8_STAGE
#undef PG8_LDA
#undef PG8_LDB
#undef PG8_MMA
#undef PG8_WAIT_V
#undef PG8_WAIT_L
#undef PG8_BAR
#undef PG8_SCHED
}
}

constexpr int NWAVES = 8, NTHREADS = NWAVES * 64;
constexpr int NPHASE = 12;
constexpr int KSZ = 256, NKS_FFN = DFF / KSZ, NKS_MIX = D / KSZ;
#ifndef MK_N_LAUNCHES
#define MK_N_LAUNCHES 1
#endif
constexpr int N_LAUNCHES = MK_N_LAUNCHES;
constexpr int RING_BYTES = 131072, LDS_BYTES = 147456;

#define GAS __attribute__((address_space(1)))
#define LAS __attribute__((address_space(3)))
typedef unsigned short bf16;
typedef unsigned v4u __attribute__((ext_vector_type(4)));
typedef unsigned v2u __attribute__((ext_vector_type(2)));
typedef float f32x4 __attribute__((ext_vector_type(4)));
#define LDS_WAIT() asm volatile("s_waitcnt lgkmcnt(0)" ::: "memory")
__device__ __forceinline__ unsigned pk2(float lo, float hi) { return pg8::cvt_pk_bf16(lo, hi); }
__device__ __forceinline__ float wave_sum(float v) {
#pragma unroll
    for (int o = 1; o < 64; o <<= 1) v += __shfl_xor(v, o);
    return v;
}

typedef GAS unsigned gu32;
#define RLX_AGENT __ATOMIC_RELAXED, __HIP_MEMORY_SCOPE_AGENT
#define VM_WAIT() asm volatile("s_waitcnt vmcnt(0)" ::: "memory")
__device__ __forceinline__ unsigned long long rt() { return __builtin_amdgcn_s_memrealtime(); }

#define XB_TMO      128
#define XB_XCNT(j)  (256  + 64 * (j))
#define XB_XSUB(j)  (1280 + 64 * (j))
#define XB_XGEN(j)  (2304 + 64 * (j))
#define XB_TOP      3328
#define XB_TOPGEN   3392
#define XCD_BAR_WORDS 3456
#define XB_SPIN_CAP (1u << 18)

__device__ __forceinline__ unsigned xb_ld(unsigned* p)              { return __hip_atomic_load(p, __ATOMIC_RELAXED, __HIP_MEMORY_SCOPE_AGENT); }
__device__ __forceinline__ unsigned xb_add(unsigned* p, unsigned v) { return __hip_atomic_fetch_add(p, v, __ATOMIC_RELAXED, __HIP_MEMORY_SCOPE_AGENT); }
__device__ __forceinline__ unsigned xb_xcc_id() { return (unsigned)__builtin_amdgcn_s_getreg((3 << 11) | 20) & 0xFu; }
#define XB_SPIN(cond, bar) do { unsigned _sp = 0; while (cond) { __builtin_amdgcn_s_sleep(1); \
    if ((++_sp & 255u) == 0u) { if (xb_ld(&(bar)[XB_TMO])) break; if (_sp > XB_SPIN_CAP) { atomicAdd(&(bar)[XB_TMO], 1u); break; } } } } while (0)

struct XcdBarrier {
    unsigned* bar; unsigned x;
    volatile LAS unsigned* st;
};

__device__ __forceinline__ XcdBarrier xcd_barrier_post(unsigned* bar, volatile LAS unsigned* st) {
    XcdBarrier b; b.bar = bar; b.x = xb_xcc_id(); b.st = st;
    if (threadIdx.x == 0) (void)xb_add(&bar[XB_XCNT(b.x)], 1u);
    return b;
}
__device__ __forceinline__ void xcd_barrier_complete(unsigned* bar, unsigned x, unsigned& nloc, unsigned& nx) {
    const unsigned G = gridDim.x * gridDim.y * gridDim.z;
    unsigned sum, cnt, mine, sp = 0u;
    for (;;) {
        sum = 0u; cnt = 0u; mine = 0u;
#pragma unroll
        for (unsigned j = 0; j < 16; ++j) { const unsigned c = xb_ld(&bar[XB_XCNT(j)]); sum += c; cnt += (c > 0u) ? 1u : 0u; mine = (j == x) ? c : mine; }
        if (sum == G) break;
        __builtin_amdgcn_s_sleep(1);
        if ((++sp & 255u) == 0u) { if (xb_ld(&bar[XB_TMO])) break; if (sp > XB_SPIN_CAP) { atomicAdd(&bar[XB_TMO], 1u); break; } }
    }
    nloc = mine > 0u ? mine : 1u; nx = cnt > 0u ? cnt : 1u;
}

__device__ __forceinline__ void xcd_barrier(const XcdBarrier& b) {
    asm volatile("s_waitcnt vmcnt(0)" ::: "memory");
    __syncthreads();
    if (threadIdx.x == 0) {
        unsigned* bar = b.bar;
        __builtin_amdgcn_s_waitcnt(0);
        unsigned nloc = b.st[0], nx = b.st[1];
        if (nloc == 0u) { xcd_barrier_complete(bar, b.x, nloc, nx); b.st[0] = nloc; b.st[1] = nx; }
        const unsigned old = xb_add(&bar[XB_XSUB(b.x)], 1u);
        const unsigned gen = old / nloc;
        if (old + 1u == (gen + 1u) * nloc) {
            __builtin_amdgcn_fence(__ATOMIC_RELEASE, "agent");
            asm volatile("s_waitcnt vmcnt(0)" ::: "memory");
            const unsigned og = xb_add(&bar[XB_TOP], 1u);
            const unsigned tg = og / nx;
            if (og + 1u == (tg + 1u) * nx) xb_add(&bar[XB_TOPGEN], 1u);
            else XB_SPIN(xb_ld(&bar[XB_TOPGEN]) == tg, bar);
            __builtin_amdgcn_fence(__ATOMIC_ACQUIRE, "agent");
            xb_add(&bar[XB_XGEN(b.x)], 1u);
            asm volatile("s_waitcnt vmcnt(0)" ::: "memory");
        } else {
            XB_SPIN(xb_ld(&bar[XB_XGEN(b.x)]) == gen, bar);
            __builtin_amdgcn_fence(__ATOMIC_ACQUIRE, "agent");
            asm volatile("s_waitcnt vmcnt(0)" ::: "memory");
        }
    }
    __syncthreads();
}

constexpr int CW_BAR = 4096, MISC_OFF = RING_BYTES + 320;
constexpr size_t CTL_ZERO_BYTES = 64 * 1024;
static_assert((CW_BAR + XCD_BAR_WORDS) * 4 <= (int)CTL_ZERO_BYTES, "ctl");

struct Args { const float* in[23]; float* out; unsigned char* ws; int ph_lo, ph_hi; };
enum { I_XP = 0, I_XS, I_CCONV, I_CPOOL, I_CP, I_CS, I_ADAW, I_ADAB, I_LNG, I_LNB, I_FWIN, I_FWDN, I_MWIN, I_MBIN, I_CONVW, I_CONVB, I_CLNG, I_CLNB, I_POOLW, I_POOLB, I_PSCALE, I_MWOUT, I_MBOUT };

__device__ __forceinline__ void transpose_item(const float* W, int ldw, bf16* WT, int ldt, int k0, int n0, int drow0, LAS float* scr, int lane) {
#pragma unroll 8
    for (int i = 0; i < 32; ++i) { const int kk = 2 * i + (lane >> 5); scr[kk * 33 + (lane & 31)] = W[(size_t)(k0 + kk) * ldw + n0 + (lane & 31)]; }
    LDS_WAIT(); asm volatile("" ::: "memory");
    const int c = lane & 7;
#pragma unroll
    for (int j = 0; j < 4; ++j) { const int n = (lane >> 3) + 8 * j; const LAS float* s = scr + (8 * c) * 33 + n;
        v4u o; o.x = pk2(s[0 * 33], s[1 * 33]); o.y = pk2(s[2 * 33], s[3 * 33]); o.z = pk2(s[4 * 33], s[5 * 33]); o.w = pk2(s[6 * 33], s[7 * 33]);
        *(v4u*)(WT + (size_t)(drow0 + n) * ldt + k0 + 8 * c) = o; }
    LDS_WAIT(); asm volatile("" ::: "memory");
}
constexpr int I_IN = (D / 64) * (2 * DFF / 32), I_DN = (DFF / 64) * (D / 32), I_MI = (D / 64) * (INC / 32), I_MO = (CC / 64) * (D / 32), I_FOLD = 64 * 16, I_B = 16;
constexpr int N_WAVE_ITEMS = 2 * I_IN + 2 * I_DN + I_MI + I_MO + I_FOLD + I_B;
static_assert(N_WAVE_ITEMS % NWAVES == 0, "wave items per block item");
constexpr int N_MOD_ITEMS = NMOD / 64, N_BLOCK_ITEMS = N_MOD_ITEMS + N_WAVE_ITEMS / NWAVES;

__device__ __forceinline__ void p0_wave_item(const Args& a, int r, LAS float* scr, int lane) {
    unsigned char* ws = a.ws;
    for (int l = 0; l < 2; ++l) { if (r < I_IN) { const int nblk = 2 * DFF / 32, kb = r / nblk, nb = r % nblk, n0 = 32 * nb, h = n0 >= DFF ? 1 : 0, j = n0 - h * DFF;
            transpose_item(a.in[I_FWIN] + (size_t)l * D * 2 * DFF, 2 * DFF, (bf16*)(ws + (l ? WS_WIN2 : WS_WIN1)), D, 64 * kb, n0, 256 * (j >> 7) + 128 * h + (j & 127), scr, lane); return; } r -= I_IN; }
    for (int l = 0; l < 2; ++l) { if (r < I_DN) { const int nblk = D / 32, kb = r / nblk, nb = r % nblk;
            transpose_item(a.in[I_FWDN] + (size_t)l * DFF * D, D, (bf16*)(ws + (l ? WS_WDN2 : WS_WDN1)), DFF, 64 * kb, 32 * nb, 32 * nb, scr, lane); return; } r -= I_DN; }
    if (r < I_MI) { const int nblk = INC / 32, kb = r / nblk, nb = r % nblk, n0 = 32 * nb; int drow = n0;
        if (n0 < 1024) { const int h = n0 >= 512 ? 1 : 0, j = n0 - 512 * h; drow = 256 * (j >> 7) + 128 * h + (j & 127); }
        transpose_item(a.in[I_MWIN], INC, (bf16*)(ws + WS_WMI), D, 64 * kb, n0, drow, scr, lane); return; } r -= I_MI;
    if (r < I_MO) { const int nblk = D / 32, kb = r / nblk, nb = r % nblk;
        transpose_item(a.in[I_MWOUT], D, (bf16*)(ws + WS_WMO), D, 64 * kb, 32 * nb, 32 * nb, scr, lane); return; } r -= I_MO;
    const float* wout = a.in[I_MWOUT]; const float* pscale = a.in[I_PSCALE];
    if (r < I_FOLD) {
        const int cg8 = r >> 4, nb = r & 15, g = cg8 >> 4, cg0 = cg8 * 8, n = nb * 64 + lane;
        const float* pw = a.in[I_POOLW] + (size_t)cg0 * 128;
        float acc[8];
#pragma unroll
        for (int e = 0; e < 8; ++e) acc[e] = 0.f;
        for (int d = 0; d < 128; ++d) { const float w = wout[(size_t)(512 + g * 128 + d) * D + n] * pscale[g * 128 + d];
#pragma unroll
            for (int e = 0; e < 8; ++e) acc[e] += pw[e * 128 + d] * w; }
        v4u o; o.x = pk2(acc[0], acc[1]); o.y = pk2(acc[2], acc[3]); o.z = pk2(acc[4], acc[5]); o.w = pk2(acc[6], acc[7]);
        *(v4u*)((bf16*)(ws + WS_WMO) + (size_t)n * D + 512 + cg0) = o; return; } r -= I_FOLD;
    {
        const int n = r * 64 + lane; const float* pb = a.in[I_POOLB]; float acc = a.in[I_MBOUT][n];
        for (int j = 0; j < PC; ++j) acc += pb[j] * pscale[j] * wout[(size_t)(512 + j) * D + n];
        ((float*)(ws + WS_BIAS2))[n] = acc; }
}
__device__ __forceinline__ void p0_mod_item(const Args& a, int item, LAS unsigned char* lds, int tid, int wave, int lane) {
    LAS float* sc = (LAS float*)lds; LAS float* red = (LAS float*)(lds + NBATCH * D * 4);
    for (int idx = tid; idx < NBATCH * D; idx += NTHREADS) { const int b = idx >> 10, k = idx & 1023; const float c = b < NB_P ? a.in[I_CP][b * D + k] : a.in[I_CS][(b - NB_P) * D + k]; sc[idx] = c / (1.0f + __expf(-c)); }
    __syncthreads();
    const int j = item * 64 + lane; const float* aw = a.in[I_ADAW] + j;
    float acc[NBATCH];
#pragma unroll
    for (int b = 0; b < NBATCH; ++b) acc[b] = 0.f;
    for (int k4 = 0; k4 < 32; ++k4) { const int kk = wave * 128 + 4 * k4;
        const float a0 = aw[(size_t)(kk + 0) * NMOD], a1 = aw[(size_t)(kk + 1) * NMOD], a2 = aw[(size_t)(kk + 2) * NMOD], a3 = aw[(size_t)(kk + 3) * NMOD];
#pragma unroll
        for (int b = 0; b < NBATCH; ++b) { const f32x4 s = *(const LAS f32x4*)(sc + b * D + kk); acc[b] += (a0 * s.x + a1 * s.y) + (a2 * s.z + a3 * s.w); } }
#pragma unroll
    for (int b = 0; b < NBATCH; ++b) red[(wave * NBATCH + b) * 64 + lane] = acc[b];
    __syncthreads();
    for (int idx = tid; idx < NBATCH * 64; idx += NTHREADS) { const int b = idx >> 6, l = idx & 63; float s = a.in[I_ADAB][item * 64 + l];
#pragma unroll
        for (int w = 0; w < NWAVES; ++w) s += red[(w * NBATCH + b) * 64 + l];
        ((float*)(a.ws + WS_MOD))[(size_t)b * NMOD + item * 64 + l] = s; }
    __syncthreads();
}

__device__ __forceinline__ void store_mod_row(const f32x4 (&v)[4], const float* MOD, int m, int kmod, bf16* U, int lane) {
    const float* mp = MOD + (size_t)batch_of_row(m) * NMOD + 3 * kmod * D; const f32x4* sh = (const f32x4*)mp + lane; const f32x4* sc = (const f32x4*)(mp + D) + lane;
    v2u* o = (v2u*)(U + (size_t)m * D) + lane;
#pragma unroll
    for (int j = 0; j < 4; ++j) { const f32x4 u = v[j] * (sc[64 * j] + 1.0f) + sh[64 * j]; v2u w; w.x = pk2(u.x, u.y); w.y = pk2(u.z, u.w); o[64 * j] = w; }
}
__device__ __forceinline__ void modulate_phase(const Args& a, int G, int wave, int lane) {
    const float* MOD = (const float*)(a.ws + WS_MOD); bf16* U = (bf16*)(a.ws + WS_U);
    for (int m = blockIdx.x * NWAVES + wave; m < M; m += G * NWAVES) {
        const f32x4* xr = (const f32x4*)(m < M_P ? a.in[I_XP] + (size_t)m * D : a.in[I_XS] + (size_t)(m - M_P) * D) + lane;
        f32x4 v[4];
#pragma unroll
        for (int j = 0; j < 4; ++j) v[j] = xr[64 * j];
        store_mod_row(v, MOD, m, 0, U, lane);
    }
}
__device__ __forceinline__ void ln_phase(const Args& a, int kln, int kmod, int G, int wave, int lane) {
    const float* MOD = (const float*)(a.ws + WS_MOD); bf16* U = (bf16*)(a.ws + WS_U); float* XY = a.out + OUT_Y;
    f32x4 gv[4], bv[4];
#pragma unroll
    for (int j = 0; j < 4; ++j) { gv[j] = ((const f32x4*)(a.in[I_LNG] + kln * D))[lane + 64 * j]; bv[j] = ((const f32x4*)(a.in[I_LNB] + kln * D))[lane + 64 * j]; }
    for (int m = blockIdx.x * NWAVES + wave; m < M; m += G * NWAVES) {
        f32x4* xr = (f32x4*)(XY + (size_t)m * D) + lane;
        f32x4 v[4]; float s = 0.f;
        if (m >= M_P) {
            const f32x4* pp = (const f32x4*)(a.ws + WS_PART) + (size_t)(m - M_P) * (D / 4) + lane;
            const f32x4* rr = kln == 0 ? (const f32x4*)(a.in[I_XS] + (size_t)(m - M_P) * D) + lane : xr;
            const f32x4* gt = (const f32x4*)(MOD + (size_t)batch_of_row(m) * NMOD + (3 * kln + 2) * D) + lane;
            const f32x4* bs = (const f32x4*)(a.ws + WS_BIAS2) + lane;
            const float gs = kln == 1 ? 1.0f : 0.5f; const int nks = kln == 1 ? NKS_MIX : NKS_FFN;
#pragma unroll
            for (int j = 0; j < 4; ++j) { f32x4 acc = kln == 1 ? bs[64 * j] : (f32x4){0.f, 0.f, 0.f, 0.f};
                for (int ks = 0; ks < nks; ++ks) acc += pp[(size_t)ks * (M_S * D / 4) + 64 * j];
                v[j] = rr[64 * j] * ALPHA + gt[64 * j] * gs * acc; }
        } else {
#pragma unroll
            for (int j = 0; j < 4; ++j) v[j] = xr[64 * j];
        }
#pragma unroll
        for (int j = 0; j < 4; ++j) s += (v[j].x + v[j].y) + (v[j].z + v[j].w);
        const float mean = wave_sum(s) * (1.f / D); float s2 = 0.f;
#pragma unroll
        for (int j = 0; j < 4; ++j) { v[j] = v[j] - mean; s2 += (v[j].x * v[j].x + v[j].y * v[j].y) + (v[j].z * v[j].z + v[j].w * v[j].w); }
        const float rstd = 1.f / sqrtf(wave_sum(s2) * (1.f / D) + LN_EPS);
#pragma unroll
        for (int j = 0; j < 4; ++j) { v[j] = v[j] * rstd * gv[j] + bv[j]; xr[64 * j] = v[j]; }
        if (kmod >= 0) store_mod_row(v, MOD, m, kmod, U, lane);
    }
}

template <int CT> __device__ __forceinline__ void convpool_unit(const Args& a, int row0, LAS unsigned char* lds, int tid, int wave, int lane) {
    const float* GLU = (const float*)(a.ws + WS_GLU); const float* ZP = (const float*)(a.ws + WS_ZP); bf16* A2 = (bf16*)(a.ws + WS_U);
    LAS float* tile = (LAS float*)lds;
    const bool samp = row0 >= M_P;
    int b, t0, Tlen, rowbase;
    if (!samp) { b = row0 >> 14; t0 = row0 & (T_P - 1); Tlen = T_P; rowbase = b * T_P; }
    else { const int r = row0 - M_P; b = r >> 6; t0 = r & (T_S - 1); Tlen = T_S; rowbase = M_P + b * T_S; }
    const bool last = (t0 + CT == Tlen);
    const int c = tid, r0 = tid >> 7;
    constexpr int NRC = CT + CH, NITC = (NRC + 3) / 4, NRP = CT + PH, NITP = (NRP + 3) / 4;
    const f32x4* safe = (const f32x4*)GLU + tid;
    f32x4 sv[NITC], pv[NITP];
    {   const f32x4* gp = (const f32x4*)GLU + ((long)(rowbase + t0 - CH) * (CC / 4) + tid);
        const f32x4* cp = (const f32x4*)a.in[I_CCONV] + ((long)(b * CH + t0) * (CC / 4) + tid);
#pragma unroll
        for (int it = 0; it < NITC; ++it) { const int r = r0 + 4 * it, ti = t0 - CH + r; const bool valid = (r < NRC) && (ti >= 0 || samp);
            const f32x4* p = ti >= 0 ? gp + it * 512 : cp + it * 512; p = valid ? p : safe; const f32x4 v = *p;
            sv[it] = valid ? v : (f32x4){0.f, 0.f, 0.f, 0.f}; } }
    {
        f32x4* st4 = (f32x4*)(a.out + (samp ? OUT_SCS : OUT_SCP) + (size_t)b * CH * CC) + tid;
#pragma unroll
        for (int it = 0; it < NITC; ++it) { const int r = r0 + 4 * it;
            if (r < NRC) { *(LAS f32x4*)(tile + (tid + it * 512) * 4) = sv[it]; if (last && r >= CT) st4[(it * 4 - CT) * (CC / 4)] = sv[it]; } }
        __syncthreads();
        float w[CW], acc[CT];
#pragma unroll
        for (int k = 0; k < CW; ++k) w[k] = a.in[I_CONVW][k * CC + c];
        const float cb = a.in[I_CONVB][c];
#pragma unroll
        for (int tt = 0; tt < CT; ++tt) acc[tt] = cb;
        float in[CT + CH];
#pragma unroll
        for (int i = 0; i < CT + CH; ++i) in[i] = tile[i * CC + c];
#pragma unroll
        for (int tt = 0; tt < CT; ++tt) {
#pragma unroll
            for (int k = 0; k < CW; ++k) acc[tt] += w[k] * in[tt + k]; }
#pragma unroll
        for (int tt = 0; tt < CT; ++tt) tile[tt * CC + c] = acc[tt];
    }
    {   const f32x4* gp = (const f32x4*)ZP + ((long)(rowbase + t0 - PH) * (PC / 4) + tid);
        const f32x4* cp = (const f32x4*)a.in[I_CPOOL] + ((long)(b * PH + t0) * (PC / 4) + tid);
#pragma unroll
        for (int it = 0; it < NITP; ++it) { const int r = r0 + 4 * it, ti = t0 - PH + r; const bool valid = (r < NRP) && (ti >= 0 || samp);
            const f32x4* p = ti >= 0 ? gp + it * 512 : cp + it * 512; p = valid ? p : safe; const f32x4 v = *p;
            pv[it] = valid ? v : (f32x4){0.f, 0.f, 0.f, 0.f}; } }
    __syncthreads();
    {
        const f32x4 g0 = ((const f32x4*)a.in[I_CLNG])[lane], g1 = ((const f32x4*)a.in[I_CLNG])[64 + lane], b0 = ((const f32x4*)a.in[I_CLNB])[lane], b1 = ((const f32x4*)a.in[I_CLNB])[64 + lane];
#pragma unroll
        for (int q = 0; q < CT / NWAVES; ++q) { const int tt = wave * (CT / NWAVES) + q;
            f32x4 v0 = *(const LAS f32x4*)(tile + tt * CC + 4 * lane), v1 = *(const LAS f32x4*)(tile + tt * CC + 256 + 4 * lane);
            const float mean = wave_sum((v0.x + v0.y) + (v0.z + v0.w) + (v1.x + v1.y) + (v1.z + v1.w)) * (1.f / CC);
            v0 = v0 - mean; v1 = v1 - mean;
            const float var = wave_sum((v0.x * v0.x + v0.y * v0.y) + (v0.z * v0.z + v0.w * v0.w) + (v1.x * v1.x + v1.y * v1.y) + (v1.z * v1.z + v1.w * v1.w)) * (1.f / CC);
            const float rstd = 1.f / sqrtf(var + LN_EPS);
            v0 = v0 * rstd * g0 + b0; v1 = v1 * rstd * g1 + b1;
            v2u w0, w1; w0.x = pk2(pg8::silu_f(v0.x), pg8::silu_f(v0.y)); w0.y = pk2(pg8::silu_f(v0.z), pg8::silu_f(v0.w));
            w1.x = pk2(pg8::silu_f(v1.x), pg8::silu_f(v1.y)); w1.y = pk2(pg8::silu_f(v1.z), pg8::silu_f(v1.w));
            bf16* op = A2 + (size_t)(row0 + tt) * D;
            *(v2u*)(op + 4 * lane) = w0; *(v2u*)(op + 256 + 4 * lane) = w1; }
    }
    __syncthreads();
    {
        f32x4* st4 = (f32x4*)(a.out + (samp ? OUT_SPS : OUT_SPP) + (size_t)b * PH * PC) + tid;
#pragma unroll
        for (int it = 0; it < NITP; ++it) { const int r = r0 + 4 * it;
            if (r < NRP) { *(LAS f32x4*)(tile + (tid + it * 512) * 4) = pv[it]; if (last && r >= CT) st4[(it * 4 - CT) * (PC / 4)] = pv[it]; } }
        __syncthreads();
        const int g = c >> 7, wnd = 2 << g;
        float in[CT + PH], s2[CT + PH], s4[CT + PH], s8[CT + PH];
        bf16* op = A2 + (size_t)row0 * D + 512 + c;
#pragma unroll
        for (int i = 0; i < CT + PH; ++i) { in[i] = tile[i * PC + c];
            s2[i] = in[i] + (i >= 1 ? in[i - 1] : 0.f); s4[i] = s2[i] + (i >= 2 ? s2[i - 2] : 0.f); s8[i] = s4[i] + (i >= 4 ? s4[i - 4] : 0.f);
            const float s16 = s8[i] + (i >= 8 ? s8[i - 8] : 0.f);
            if (i >= PH) { const int tt = i - PH; const float wsum = g == 0 ? s2[i] : g == 1 ? s4[i] : g == 2 ? s8[i] : s16;
                const int pos = (samp ? PAST : 0) + t0 + tt; const int cnt = pos + 1 < wnd ? pos + 1 : wnd;
                const float pooled = wsum / (float)cnt - in[i];
                op[(size_t)tt * D] = (bf16)(pk2(pooled, 0.f) & 0xffffu); } }
    }
    __syncthreads();
}

#define SAMPLE_SPLITK(Aptr, WOFF, KTOT, NKS) do { pg8::Gemm g2{(Aptr), (const bf16*)(ws + (WOFF)), M_S, D, KSZ, (KTOT)}; pg8::SplitOrder S2; S2.init(M_S, D, (NKS), KSZ, G, (int)blockIdx.x); \
        pg8::EpiPartial E2{(float*)(ws + WS_PART), KSZ, (size_t)M_S * D}; pg8::gemm_phase<pg8::EpiPartial, pg8::SplitOrder, true, true>(lds, g2, S2, E2); } while (0)
__global__ void __launch_bounds__(NTHREADS, 2) mk_fwd(Args a) {
    extern __shared__ __attribute__((aligned(16))) unsigned char lds_raw[];
    LAS unsigned char* lds = (LAS unsigned char*)lds_raw;
    const int tid0 = threadIdx.x, G = gridDim.x;
#define PHASE_IDS int tid = threadIdx.x; asm volatile("" : "+v"(tid)); const int lane = tid & 63, wave = __builtin_amdgcn_readfirstlane(tid >> 6)
    const int lo = a.ph_lo, hi = a.ph_hi;
    unsigned char* ws = a.ws;
    const float* MOD = (const float*)(ws + WS_MOD);
    bf16* U = (bf16*)(ws + WS_U); bf16* ACT = (bf16*)(ws + WS_ACT);
    float* XY = a.out + OUT_Y;
#define IN(k) (lo <= (k) && (k) < hi)
#define SEAM(k) do { if (IN(k) && IN((k) + 1)) xcd_barrier(bar); } while (0)
#if defined(PROBE_PHASE)
    unsigned long long ts_a = 0, ts_b = 0;
#define STAMP(k) do { if ((k) == PROBE_PHASE) ts_a = rt(); if ((k) == PROBE_PHASE + 1) ts_b = rt(); } while (0)
#else
#define STAMP(k) do {} while (0)
#endif

    for (int u = tid0; u < (LDS_BYTES - RING_BYTES) / 4; u += NTHREADS) ((LAS unsigned*)(lds + RING_BYTES))[u] = 0u;
    __syncthreads();
    if (lo < 0) cg::this_grid().sync();
    XcdBarrier bar; bar.bar = (unsigned*)(ws + WS_CTL) + CW_BAR; bar.x = 0; bar.st = nullptr;
    if (hi - lo > 1) bar = xcd_barrier_post((unsigned*)(ws + WS_CTL) + CW_BAR, (volatile LAS unsigned*)(lds + MISC_OFF + 32));
    STAMP(0); if (IN(0)) { PHASE_IDS;
        for (int bi = blockIdx.x; bi < N_BLOCK_ITEMS; bi += G) {
            if (bi < N_MOD_ITEMS) p0_mod_item(a, bi, lds, tid, wave, lane);
            else p0_wave_item(a, (bi - N_MOD_ITEMS) * NWAVES + wave, (LAS float*)(lds + wave * 16384), lane);
        }
    }
    SEAM(0);
    STAMP(1); if (IN(1)) { PHASE_IDS; (void)tid; modulate_phase(a, G, wave, lane); }
    SEAM(1);
    STAMP(2); if (IN(2)) { pg8::Gemm g{U, (const bf16*)(ws + WS_WIN1), M, 2 * DFF, D, D}; pg8::StaticOrder S; S.init(M, 2 * DFF, G, (int)blockIdx.x);
        pg8::EpiSwiGLU E{ACT, DFF}; pg8::gemm_phase<pg8::EpiSwiGLU, pg8::StaticOrder, true, true>(lds, g, S, E); }
    SEAM(2);
    STAMP(3); if (IN(3)) { { pg8::Gemm g{ACT, (const bf16*)(ws + WS_WDN1), M_P, D, DFF, DFF}; pg8::StaticOrder S; S.init(M_P, D, G, (int)blockIdx.x);
        pg8::EpiResid E{a.in[I_XP], a.in[I_XS], XY, MOD + 2 * D, nullptr, 0.5f}; pg8::gemm_phase<pg8::EpiResid, pg8::StaticOrder, true, true>(lds, g, S, E); }
        SAMPLE_SPLITK(ACT + (size_t)M_P * DFF, WS_WDN1, DFF, NKS_FFN); }
    SEAM(3);
    STAMP(4); if (IN(4)) { PHASE_IDS; (void)tid; ln_phase(a, 0, 1, G, wave, lane); }
    SEAM(4);
    STAMP(5); if (IN(5)) { pg8::Gemm g{U, (const bf16*)(ws + WS_WMI), M, INC, D, D}; pg8::StaticOrder S; S.init(M, INC, G, (int)blockIdx.x);
        pg8::EpiMixIn E{(float*)(ws + WS_GLU), (float*)(ws + WS_ZP), a.in[I_MBIN]}; pg8::gemm_phase<pg8::EpiMixIn, pg8::StaticOrder, true, true>(lds, g, S, E); }
    SEAM(5);
    STAMP(6); if (IN(6)) { PHASE_IDS; for (int u = blockIdx.x; u < M_P / 32 + M_S / 8; u += G) { if (u < M_P / 32) convpool_unit<32>(a, u * 32, lds, tid, wave, lane); else convpool_unit<8>(a, M_P + (u - M_P / 32) * 8, lds, tid, wave, lane); } }
    SEAM(6);
    STAMP(7); if (IN(7)) { { pg8::Gemm g{U, (const bf16*)(ws + WS_WMO), M_P, D, D, D}; pg8::StaticOrder S; S.init(M_P, D, G, (int)blockIdx.x);
        pg8::EpiResid E{XY, XY + (size_t)M_P * D, XY, MOD + 5 * D, (const float*)(ws + WS_BIAS2), 1.0f}; pg8::gemm_phase<pg8::EpiResid, pg8::StaticOrder, true, true>(lds, g, S, E); }
        SAMPLE_SPLITK(U + (size_t)M_P * D, WS_WMO, D, NKS_MIX); }
    SEAM(7);
    STAMP(8); if (IN(8)) { PHASE_IDS; (void)tid; ln_phase(a, 1, 2, G, wave, lane); }
    SEAM(8);
    STAMP(9); if (IN(9)) { pg8::Gemm g{U, (const bf16*)(ws + WS_WIN2), M, 2 * DFF, D, D}; pg8::StaticOrder S; S.init(M, 2 * DFF, G, (int)blockIdx.x);
        pg8::EpiSwiGLU E{ACT, DFF}; pg8::gemm_phase<pg8::EpiSwiGLU, pg8::StaticOrder, true, true>(lds, g, S, E); }
    SEAM(9);
    STAMP(10); if (IN(10)) { { pg8::Gemm g{ACT, (const bf16*)(ws + WS_WDN2), M_P, D, DFF, DFF}; pg8::StaticOrder S; S.init(M_P, D, G, (int)blockIdx.x);
        pg8::EpiResid E{XY, XY + (size_t)M_P * D, XY, MOD + 8 * D, nullptr, 0.5f}; pg8::gemm_phase<pg8::EpiResid, pg8::StaticOrder, true, true>(lds, g, S, E); }
        SAMPLE_SPLITK(ACT + (size_t)M_P * DFF, WS_WDN2, DFF, NKS_FFN); }
    SEAM(10);
    STAMP(11); if (IN(11)) { PHASE_IDS; (void)tid; ln_phase(a, 2, -1, G, wave, lane); }
    STAMP(12);
#if defined(PROBE_PHASE)
    if (blockIdx.x == 0 && threadIdx.x == 0) { const unsigned long long dur = (ts_b - ts_a) * 4ull; const unsigned long long t0 = rt(); while (rt() - t0 < dur) __builtin_amdgcn_s_sleep(32); }
#endif
#undef IN
#undef SEAM
}

extern "C" void kernel_launch(void* const* d_in, const int* in_sizes, int n_in, void* d_out, int out_size, void* d_ws, size_t ws_size, hipStream_t stream) {
    static int grid = 0;
    if (grid == 0) {
        if (n_in != 23 || in_sizes[0] != M_P * D || in_sizes[1] != M_S * D || (size_t)out_size != OUT_END || ws_size < WS_END) {
            fprintf(stderr, "kernel_launch: unexpected shapes (n_in %d, in0 %d, out %d, ws %zu); nothing launched\n", n_in, n_in > 0 ? in_sizes[0] : -1, out_size, ws_size); grid = -1; return; }
        int dev = 0, cus = 0, per_cu = 0;
        if (hipGetDevice(&dev) != hipSuccess || hipDeviceGetAttribute(&cus, hipDeviceAttributeMultiprocessorCount, dev) != hipSuccess) { fprintf(stderr, "kernel_launch: device query failed\n"); grid = -1; return; }
        if (hipFuncSetAttribute((const void*)mk_fwd, hipFuncAttributeMaxDynamicSharedMemorySize, LDS_BYTES) != hipSuccess) { fprintf(stderr, "kernel_launch: hipFuncSetAttribute failed\n"); grid = -1; return; }
        if (hipOccupancyMaxActiveBlocksPerMultiprocessor(&per_cu, (const void*)mk_fwd, NTHREADS, LDS_BYTES) != hipSuccess || per_cu < 1) { per_cu = 1; (void)hipGetLastError(); }
        grid = cus * per_cu;
    }
    if (grid < 0) return;
    if (hipMemsetAsync((char*)d_ws + WS_CTL, 0, CTL_ZERO_BYTES, stream) != hipSuccess) { fprintf(stderr, "kernel_launch: memset failed\n"); return; }
    Args a{};
    for (int i = 0; i < 23; ++i) a.in[i] = (const float*)d_in[i];
    a.out = (float*)d_out; a.ws = (unsigned char*)d_ws;
    if (N_LAUNCHES == 1) {
        a.ph_lo = 0; a.ph_hi = NPHASE;
        void* kargs[] = {&a};
        const hipError_t e = hipLaunchCooperativeKernel((const void*)mk_fwd, dim3(grid), dim3(NTHREADS), kargs, LDS_BYTES, stream);
        if (e != hipSuccess) fprintf(stderr, "kernel_launch: cooperative launch failed: %s (grid %d)\n", hipGetErrorString(e), grid);
    } else {
        for (int p = 0; p < NPHASE; ++p) { a.ph_lo = p; a.ph_hi = p + 1; hipLaunchKernelGGL(mk_fwd, dim3(grid), dim3(NTHREADS), LDS_BYTES, stream, a); }
    }
}
```
